# Optimizing an MI355X kernel written in HIP

```python
import math
import jax, jax.numpy as jnp
from jax import lax
import numpy as np

D_MODEL = 1024
BATCH = 2
SEQ = 8192
DEPTH = 4

N_META = 16
BLOCK = 128
FRONT = BLOCK
BR_WIDTH = D_MODEL // 2
N_BRANCH = 4
HG_HEADS = 4
HG_DK = BR_WIDTH // HG_HEADS
SB_HEADS = 8
SB_DH = BR_WIDTH // SB_HEADS
POOL_WINDOWS = (2, 4, 8, 16)
POOL_GROUP = BR_WIDTH // len(POOL_WINDOWS)
CONV_WIDTH = 3
D_FF = 4 * D_MODEL
N_SPLIT = 11
IN_COLS = N_SPLIT * BR_WIDTH + N_BRANCH * D_MODEL
EPS = 1e-6

kernel_name = "hybrid_hgrn2_pool_stickbreak_shortconv"

F32 = jnp.float32


def rmsnorm(x, g):
    xf = x.astype(F32)
    y = xf * lax.rsqrt(jnp.mean(xf * xf, axis=-1, keepdims=True) + EPS)
    return (y * g.astype(F32)).astype(x.dtype)


def hgrn2_mixer(q, f_logit, i, g, lb, valid, norm_g):
    B_, L, _ = q.shape
    n_chunks = L // BLOCK
    vmask = valid[None, :, None]
    xf = f_logit.astype(F32)
    log_f = jnp.where(vmask, jnp.log(lb + (1.0 - lb) * jax.nn.sigmoid(xf)), 0.0)
    k = jnp.where(vmask, (1.0 - lb) * jax.nn.sigmoid(-xf), 0.0)
    qf = q.astype(F32)
    vf = jnp.where(vmask, i.astype(F32), 0.0)

    def to_chunks(a):
        return a.reshape(B_, n_chunks, BLOCK, HG_HEADS, HG_DK).transpose(1, 0, 2, 3, 4)

    causal = jnp.tril(jnp.ones((BLOCK, BLOCK), bool))[None, :, :, None, None]

    def step(S, inp):
        qc, kc, ic, lfc = inp
        b = jnp.cumsum(lfc, axis=1)
        o_inter = jnp.einsum('bthk,bhkv->bthv', qc * jnp.exp(b), S)
        diff = b[:, :, None] - b[:, None, :]
        decay = jnp.exp(jnp.where(causal, diff, -jnp.inf))
        scores = jnp.einsum('bthk,btshk,bshk->bhts', qc, decay, kc)
        o_intra = jnp.einsum('bhts,bshv->bthv', scores, ic)
        b_last = b[:, -1]
        S_new = jnp.exp(b_last)[..., None] * S + jnp.einsum(
            'bshk,bshv->bhkv', kc * jnp.exp(b_last[:, None] - b), ic)
        return S_new, o_inter + o_intra

    S0 = jnp.zeros((B_, HG_HEADS, HG_DK, HG_DK), F32)
    _, o = lax.scan(step, S0, (to_chunks(qf), to_chunks(k), to_chunks(vf), to_chunks(log_f)))
    o = o.transpose(1, 0, 2, 3, 4).reshape(B_, L, HG_HEADS, HG_DK)
    o = o * lax.rsqrt(jnp.mean(o * o, axis=-1, keepdims=True) + EPS)
    o = o * norm_g.astype(F32).reshape(HG_HEADS, HG_DK)
    o = o.reshape(B_, L, BR_WIDTH) * jax.nn.sigmoid(g.astype(F32))
    return o.astype(q.dtype)


def multiscale_pool(v, valid, pool_w, pool_scale):
    B_, L, _ = v.shape
    vf = jnp.where(valid[None, :, None], v.astype(F32), 0.0)
    cs = jnp.cumsum(vf, axis=1)
    cnt = jnp.cumsum(valid.astype(F32))
    means = []
    for gi, w in enumerate(POOL_WINDOWS):
        c = cs[:, :, gi * POOL_GROUP:(gi + 1) * POOL_GROUP]
        c_prev = jnp.pad(c, ((0, 0), (w, 0), (0, 0)))[:, :L]
        n_win = jnp.maximum(cnt - jnp.pad(cnt, (w, 0))[:L], 1.0)
        means.append((c - c_prev) / n_win[None, :, None])
    u = (jnp.concatenate(means, axis=-1) - vf).reshape(B_, L, len(POOL_WINDOWS), POOL_GROUP)
    y = jnp.einsum('blgc,gcd->blgd', u, pool_w.astype(F32)).reshape(B_, L, BR_WIDTH)
    return (y * pool_scale.astype(F32)).astype(v.dtype)


def stick_breaking_attention(q, k, v, valid):
    B_, L, _ = q.shape
    n_blk = L // BLOCK
    scale = 1.0 / math.sqrt(SB_DH)
    qh = q.astype(F32).reshape(B_, n_blk, BLOCK, SB_HEADS, SB_DH).transpose(1, 0, 2, 3, 4)
    kh = k.astype(F32).reshape(B_, L, SB_HEADS, SB_DH)
    vh = v.astype(F32).reshape(B_, L, SB_HEADS, SB_DH)
    key_pos = jnp.arange(L)

    def one_block(args):
        q_blk, start = args
        q_pos = start + jnp.arange(BLOCK)
        mask = (key_pos[None, :] < q_pos[:, None]) & valid[None, :]
        z = jnp.einsum('bqhd,bkhd->bhqk', q_blk, kh) * scale
        log_keep = jnp.where(mask, jax.nn.log_sigmoid(-z), 0.0)
        between = lax.cumsum(log_keep, axis=3, reverse=True) - log_keep
        A = jnp.where(mask, jnp.exp(jax.nn.log_sigmoid(z) + between), 0.0)
        return jnp.einsum('bhqk,bkhd->bqhd', A, vh)

    o = lax.map(one_block, (qh, jnp.arange(n_blk) * BLOCK))
    return o.transpose(1, 0, 2, 3, 4).reshape(B_, L, BR_WIDTH).astype(q.dtype)


def short_conv_mixer(h_in, b_gate, c_gate, conv_w, valid):
    u = jnp.where(valid[None, :, None], c_gate * h_in, 0.0).astype(h_in.dtype)
    y = lax.conv_general_dilated(
        u, conv_w.astype(h_in.dtype)[:, None, :], window_strides=(1,),
        padding=[(CONV_WIDTH - 1, 0)], dimension_numbers=('NWC', 'WIO', 'NWC'),
        feature_group_count=BR_WIDTH)
    return b_gate * y


def hybrid_layer(x, valid, lb, norm1_g, w_in, hg_norm_g, pool_w, pool_scale, conv_w,
                 w_branch, w_o, norm2_g, w_up, w_down):
    B_, L, _ = x.shape
    h = rmsnorm(x, norm1_g)
    proj = jnp.einsum('bld,dc->blc', h, w_in)
    split_at = [BR_WIDTH * (j + 1) for j in range(N_SPLIT)]
    (hg_q, hg_f, hg_i, hg_g, pool_v, sb_q, sb_k, sb_v,
     sc_h, sc_b, sc_c, gate_logits) = jnp.split(proj, split_at, axis=-1)

    branches = (
        hgrn2_mixer(hg_q, hg_f, hg_i, hg_g, lb, valid, hg_norm_g),
        multiscale_pool(pool_v, valid, pool_w, pool_scale),
        stick_breaking_attention(sb_q, sb_k, sb_v, valid),
        short_conv_mixer(sc_h, sc_b, sc_c, conv_w, valid),
    )
    gates = jax.nn.sigmoid(gate_logits.astype(F32)).reshape(B_, L, N_BRANCH, D_MODEL)
    mixed = jnp.zeros((B_, L, D_MODEL), F32)
    for n in range(N_BRANCH):
        mixed = mixed + gates[:, :, n] * jnp.einsum('blw,wd->bld', branches[n], w_branch[n]).astype(F32)
    x = x + jnp.einsum('bld,de->ble', mixed.astype(x.dtype), w_o)

    h2 = rmsnorm(x, norm2_g)
    act = jnp.square(jax.nn.relu(jnp.einsum('bld,df->blf', h2, w_up)))
    return x + jnp.einsum('blf,fd->bld', act, w_down)


def setup_inputs(seed: int = 0) -> dict:
    key = jax.random.key(seed)
    ks = jax.random.split(key, 16)

    def nrm(k, shape, fan_in):
        return jax.random.normal(k, shape, F32) * (fan_in ** -0.5)

    def gain(k, shape, s=0.02):
        return 1.0 + s * jax.random.normal(k, shape, F32)

    return {
        "x": jax.random.normal(ks[0], (BATCH, SEQ, D_MODEL), F32),
        "meta_tokens": jax.random.normal(ks[1], (N_META, D_MODEL), F32),
        "lb_logits": 0.5 * jax.random.normal(ks[2], (DEPTH, BR_WIDTH), F32),
        "norm1_g": gain(ks[3], (DEPTH, D_MODEL)),
        "w_in": nrm(ks[4], (DEPTH, D_MODEL, IN_COLS), D_MODEL),
        "hg_norm_g": gain(ks[5], (DEPTH, BR_WIDTH)),
        "pool_w": nrm(ks[6], (DEPTH, len(POOL_WINDOWS), POOL_GROUP, POOL_GROUP), POOL_GROUP),
        "pool_scale": gain(ks[7], (DEPTH, BR_WIDTH), 0.1),
        "conv_w": nrm(ks[8], (DEPTH, CONV_WIDTH, BR_WIDTH), CONV_WIDTH),
        "w_branch": nrm(ks[9], (DEPTH, N_BRANCH, BR_WIDTH, D_MODEL), BR_WIDTH),
        "w_o": nrm(ks[10], (DEPTH, D_MODEL, D_MODEL), D_MODEL),
        "norm2_g": gain(ks[11], (DEPTH, D_MODEL)),
        "w_up": nrm(ks[12], (DEPTH, D_MODEL, D_FF), D_MODEL),
        "w_down": nrm(ks[13], (DEPTH, D_FF, D_MODEL), D_FF),
        "final_norm_g": gain(ks[14], (D_MODEL,)),
    }


def reference(x, meta_tokens, lb_logits, norm1_g, w_in, hg_norm_g, pool_w, pool_scale, conv_w,
              w_branch, w_o, norm2_g, w_up, w_down, final_norm_g):
    B_, S_, _ = x.shape
    dt = x.dtype
    lead = jnp.concatenate([jnp.zeros((FRONT - N_META, D_MODEL), dt), meta_tokens.astype(dt)], axis=0)
    h = jnp.concatenate([jnp.broadcast_to(lead[None], (B_, FRONT, D_MODEL)), x], axis=1)
    L = FRONT + S_
    valid = jnp.arange(L) >= (FRONT - N_META)
    cum = jnp.cumsum(jax.nn.softmax(lb_logits.astype(F32), axis=0), axis=0)
    lower_bounds = cum - cum[0]
    for layer in range(DEPTH):
        h = hybrid_layer(h, valid, lower_bounds[layer], norm1_g[layer], w_in[layer], hg_norm_g[layer],
                         pool_w[layer], pool_scale[layer], conv_w[layer], w_branch[layer], w_o[layer],
                         norm2_g[layer], w_up[layer], w_down[layer])
    return rmsnorm(h[:, FRONT:], final_norm_g)
```

```cpp
#define MEGA 1
#include <hip/hip_runtime.h>
#include <hip/hip_cooperative_groups.h>
#include <cstdio>
#include <cstdint>
namespace cg = cooperative_groups;

#define LAS __attribute__((address_space(3)))
typedef unsigned short bf16_t;
typedef short bf16x8 __attribute__((ext_vector_type(8)));
typedef float f32x4 __attribute__((ext_vector_type(4)));
typedef float f32x2 __attribute__((ext_vector_type(2)));
typedef unsigned u32x4 __attribute__((ext_vector_type(4)));
typedef unsigned u32x2 __attribute__((ext_vector_type(2)));

constexpr int DM = 1024, BATCH = 2, SEQ = 8192, DEPTH = 4, FRONT = 128, NVALID0 = 112, LSEQ = 8320, ROWS = BATCH * LSEQ;
constexpr int BW = 512, INC = 9728, DFF = 4096, NCH = 65;
constexpr float EPS = 1e-6f;
constexpr int NT = 512, NWAVES = 8;

constexpr size_t al(size_t x) { return (x + 4095) & ~(size_t)4095; }
constexpr size_t SZ_G = (size_t)ROWS * BW * 2;
constexpr size_t WS_LB = 0;
constexpr size_t WS_PWT = al(WS_LB + 4 * 512 * 4);
constexpr size_t WS_DEC = al(WS_PWT + 4 * 4 * 128 * 128 * 2);
constexpr size_t WS_ST1 = al(WS_DEC + 2 * 65 * 4 * 128 * 4);
constexpr size_t WS_ST2 = al(WS_ST1 + (size_t)ROWS * 16 * 4);
constexpr size_t WS_WIN = al(WS_ST2 + (size_t)ROWS * 16 * 4);
constexpr size_t WS_WBR = al(WS_WIN + (size_t)INC * DM * 2);
constexpr size_t WS_WO = al(WS_WBR + (size_t)4 * DM * BW * 2);
constexpr size_t WS_WUP = al(WS_WO + (size_t)DM * DM * 2);
constexpr size_t WS_WDN = al(WS_WUP + (size_t)DFF * DM * 2);
constexpr size_t WS_X = al(WS_WDN + (size_t)DFF * DM * 2);
constexpr size_t WS_XN = al(WS_X + (size_t)ROWS * DM * 4);
constexpr size_t WS_MIX = al(WS_XN + (size_t)ROWS * DM * 2);
constexpr size_t WS_MIXEDB = WS_MIX + 3 * SZ_G;
constexpr size_t WS_POOLO = al(WS_MIX + 9 * SZ_G);
constexpr size_t WS_IT = al(WS_POOLO + SZ_G);
constexpr size_t WS_VT = al(WS_IT + SZ_G);
constexpr size_t WS_GATE = al(WS_VT + SZ_G);
constexpr size_t WS_H = WS_GATE;
constexpr size_t WS_LOGF = al(WS_GATE + (size_t)ROWS * DFF * 2);
constexpr size_t WS_DS = WS_LOGF + (size_t)ROWS * BW * 4;
constexpr size_t WS_MIXEDF = WS_LOGF;
constexpr size_t WS_SPREV = al(WS_DS + (size_t)ROWS * BW * 4);
constexpr size_t WS_END = al(WS_SPREV + SZ_G);
static_assert(WS_DS + (size_t)ROWS * BW * 4 == WS_MIXEDF + (size_t)ROWS * DM * 4, "MIXEDF overlay");

constexpr int LDS_BYTES = 147456;

typedef __bf16 bf16x2_t __attribute__((ext_vector_type(2)));
__device__ __forceinline__ unsigned cvt_pk_bf16(float lo, float hi) { const f32x2 v = {lo, hi}; return __builtin_bit_cast(unsigned, __builtin_convertvector(v, bf16x2_t)); }
__device__ __forceinline__ float bflo(unsigned w) { return __uint_as_float(w << 16); }
__device__ __forceinline__ float bfhi(unsigned w) { return __uint_as_float(w & 0xffff0000u); }
__device__ __forceinline__ float bf2f(bf16_t u) { return __uint_as_float(((unsigned)u) << 16); }
__device__ __forceinline__ bf16_t f2bf(float f) { return (bf16_t)(cvt_pk_bf16(f, 0.f) & 0xffffu); }
__device__ __forceinline__ float sigmoidf_(float v) { return __builtin_amdgcn_rcpf(1.0f + __expf(-v)); }
__device__ __forceinline__ float wave_sum(float v) {
#pragma unroll
    for (int o = 1; o < 64; o <<= 1) v += __shfl_xor(v, o);
    return v;
}
__device__ __forceinline__ void unpack8(const u32x4 w, float (&f)[8]) {
    f[0] = bflo(w.x); f[1] = bfhi(w.x); f[2] = bflo(w.y); f[3] = bfhi(w.y); f[4] = bflo(w.z); f[5] = bfhi(w.z); f[6] = bflo(w.w); f[7] = bfhi(w.w);
}
__device__ __forceinline__ bf16x8 pack8(const float (&f)[8]) {
    u32x4 w; w.x = cvt_pk_bf16(f[0], f[1]); w.y = cvt_pk_bf16(f[2], f[3]); w.z = cvt_pk_bf16(f[4], f[5]); w.w = cvt_pk_bf16(f[6], f[7]);
    return __builtin_bit_cast(bf16x8, w);
}
#define MFMA16(a, b, c) __builtin_amdgcn_mfma_f32_16x16x32_bf16((a), (b), (c), 0, 0, 0)

struct Params {
    const float *x, *meta, *lb_logits, *norm1_g, *w_in, *hg_norm_g, *pool_w, *pool_scale, *conv_w, *w_branch, *w_o, *norm2_g, *w_up, *w_down, *final_g;
    float* out; unsigned char* ws;
};
namespace pg8 {
constexpr int BM = 256, BK = 64, HALF = 128, HTB = HALF * BK * 2, STAGE_BYTES = 8 * HTB, NXCD = 8, WGM = 8;
__device__ __forceinline__ int lds_byte(int r, int c) { const int st = (r >> 4) * 2 + (c >> 5), rr = r & 15, cc = c & 31, ob = rr * 64 + cc * 2; return st * 1024 + (ob ^ (((ob >> 9) & 1) << 5)); }
__device__ __forceinline__ void stage_rc(int b, int& R, int& C) { const int st = b / 1024, sb = b % 1024, swz = sb ^ (((sb >> 9) & 1) << 5); R = (st >> 1) * 16 + swz / 64; C = (st & 1) * 32 + (swz % 64) / 2; }
__device__ __forceinline__ int perm32(int rho) { const int n = rho >> 4, i = rho & 15; return 8 * (i >> 2) + 4 * n + (i & 3); }

struct Unit { int pm, pn, z; const char* a; const char* b; };

struct TileOrder {
    int nM, nN, nwg;
    __device__ __forceinline__ void init(int M, int N) { nM = M / BM; nN = N / BM; nwg = nM * nN; }
    __device__ __forceinline__ bool tile(long L, int& pm, int& pn) const {
        if (L >= nwg) return false;
        int wgid = (int)L; { const int q = nwg / NXCD, r = nwg % NXCD, xcd = wgid % NXCD, off = wgid / NXCD; wgid = (xcd < r ? xcd * (q + 1) : r * (q + 1) + (xcd - r) * q) + off; }
        const int nig = WGM * nN, gid = wgid / nig, fm = gid * WGM, gsz = (nM - fm) < WGM ? (nM - fm) : WGM;
        pm = fm + ((wgid % nig) % gsz); pn = (wgid % nig) / gsz; return true;
    }
};
struct SchedPlain {
    TileOrder T; int G, c; const char* A; const char* B; size_t astep, bstep;
    __device__ __forceinline__ bool next(int i, Unit& u) const {
        if (!T.tile((long)i * G + c, u.pm, u.pn)) return false;
        u.z = 0; u.a = A + (size_t)u.pm * astep; u.b = B + (size_t)u.pn * bstep; return true;
    }
};
struct SchedBranch {
    TileOrder T; int G, c; const char *A0, *A1, *A2, *A3; const char* B; size_t astep, bstep, bz;
    __device__ __forceinline__ bool next(int i, Unit& u) const {
        if (!T.tile((long)(i >> 2) * G + c, u.pm, u.pn)) return false;
        u.z = i & 3; const char* ab = u.z == 0 ? A0 : (u.z == 1 ? A1 : (u.z == 2 ? A2 : A3));
        u.a = ab + (size_t)u.pm * astep; u.b = B + (size_t)u.z * bz + (size_t)u.pn * bstep; return true;
    }
};

template <class Epi, class Sched>
__device__ __forceinline__ void gemm_phase(LAS unsigned char* lds, const int tid, const int lda, const int ldb, const int K, const Sched& S, const Epi& E) {
    const int wid = __builtin_amdgcn_readfirstlane(tid >> 6), lane = tid & 63, wr = wid >> 2, wc = wid & 3, fr = lane & 15, fq = lane >> 4;
    const int nt = K / BK;
    unsigned voffA[2], voffB[2];
#pragma unroll
    for (int i = 0; i < 2; ++i) { int R, C; stage_rc(tid * 16 + i * 8192, R, C); const int Rb = Epi::PERM ? ((R & ~31) + perm32(R & 31)) : R;
        voffA[i] = (unsigned)(R * lda + C) * 2u; voffB[i] = (unsigned)(Rb * ldb + C) * 2u; }
    const size_t kstep = (size_t)(BK * 2);
    const size_t hstepA = (size_t)HALF * lda * 2, hstepB = (size_t)HALF * ldb * 2;
    const unsigned ldsw = (unsigned)wid * 1024u;
    const int aoff = lds_byte(wr * 64 + fr, fq * 8), boff = lds_byte(wc * 32 + fr, fq * 8);
#define PG8_SA(b, h) (((b) * 2 + (h)) * HTB)
#define PG8_SB(b, h) ((4 + (b) * 2 + (h)) * HTB)
#define PG8_STAGE(bufoff, gbase, voff) do { _Pragma("unroll") for (int _i = 0; _i < 2; ++_i) \
        __builtin_amdgcn_global_load_lds((const unsigned*)((const char*)(gbase) + (voff)[_i]), (LAS unsigned*)(lds + (bufoff) + ldsw + _i * 8192), 16, 0, 0); } while (0)
#define PG8_LDA(dst, b, h) do { _Pragma("unroll") for (int m = 0; m < 4; ++m) _Pragma("unroll") for (int k = 0; k < 2; ++k) dst[m][k] = *(const LAS bf16x8*)(lds + PG8_SA(b, h) + aoff + m * 2048 + k * 1024); } while (0)
#define PG8_LDB(dst, b, h) do { _Pragma("unroll") for (int n = 0; n < 2; ++n) _Pragma("unroll") for (int k = 0; k < 2; ++k) dst[n][k] = *(const LAS bf16x8*)(lds + PG8_SB(b, h) + boff + n * 2048 + k * 1024); } while (0)
#define PG8_MMA(ai, bj, At, Bt) do { __builtin_amdgcn_s_setprio(1); _Pragma("unroll") for (int m = 0; m < 4; ++m) _Pragma("unroll") for (int n = 0; n < 2; ++n) _Pragma("unroll") for (int k = 0; k < 2; ++k) \
        acc[ai][bj][m][n] = __builtin_amdgcn_mfma_f32_16x16x32_bf16(Bt[n][k], At[m][k], acc[ai][bj][m][n], 0, 0, 0); __builtin_amdgcn_s_setprio(0); } while (0)
#define PG8_WAIT_V(n) asm volatile("s_waitcnt vmcnt(" #n ")" ::: "memory")
#define PG8_WAIT_L(n) asm volatile("s_waitcnt lgkmcnt(" #n ")" ::: "memory")
#define PG8_BAR __builtin_amdgcn_s_barrier()
#define PG8_SCHED __builtin_amdgcn_sched_barrier(0)
    Unit cur, nxt; int ui = 0;
    if (!S.next(0, cur)) return;
    f32x4 acc[2][2][4][2];
#pragma unroll
    for (int a = 0; a < 2; ++a)
#pragma unroll
        for (int b = 0; b < 2; ++b)
#pragma unroll
            for (int m = 0; m < 4; ++m)
#pragma unroll
                for (int n = 0; n < 2; ++n) acc[a][b][m][n] = (f32x4){0.f, 0.f, 0.f, 0.f};
    bf16x8 At[4][2], B0[2][2], B1[2][2];
    const char* cA = cur.a; const char* cB = cur.b;
    PG8_STAGE(PG8_SB(0, 0), cB, voffB); PG8_STAGE(PG8_SB(0, 1), cB + hstepB, voffB); PG8_STAGE(PG8_SA(0, 0), cA, voffA); PG8_STAGE(PG8_SA(0, 1), cA + hstepA, voffA);
    if (wr == 1) PG8_BAR;
    PG8_WAIT_V(2); PG8_BAR;
    PG8_STAGE(PG8_SB(1, 0), cB + kstep, voffB); PG8_STAGE(PG8_SA(1, 0), cA + kstep, voffA); PG8_STAGE(PG8_SB(1, 1), cB + hstepB + kstep, voffB);
    PG8_WAIT_V(6); PG8_BAR;
    for (;;) {
        const bool has_next = S.next(ui + 1, nxt);
        const char* nA = has_next ? nxt.a : cA; const char* nB = has_next ? nxt.b : cB;
        for (int t = 0; t < nt; t += 2) {
            const bool last = (t == nt - 2);
            const char* a1 = cA + (size_t)(t + 1) * kstep;
            const char* a2 = last ? nA : cA + (size_t)(t + 2) * kstep; const char* b2 = last ? nB : cB + (size_t)(t + 2) * kstep;
            const char* a3 = a2 + kstep; const char* b3 = b2 + kstep;
            PG8_LDB(B0, 0, 0); PG8_LDB(B1, 0, 1); PG8_SCHED; PG8_LDA(At, 0, 0); PG8_STAGE(PG8_SA(1, 1), a1 + hstepA, voffA);
            PG8_WAIT_V(8); PG8_WAIT_L(0); PG8_BAR; PG8_MMA(0, 0, At, B0); PG8_MMA(0, 1, At, B1); PG8_BAR; PG8_SCHED;
            PG8_LDA(At, 0, 1); PG8_STAGE(PG8_SB(0, 0), b2, voffB); PG8_STAGE(PG8_SB(0, 1), b2 + hstepB, voffB); PG8_STAGE(PG8_SA(0, 0), a2, voffA);
            PG8_WAIT_V(8); PG8_WAIT_L(0); PG8_BAR; PG8_MMA(1, 0, At, B0); PG8_MMA(1, 1, At, B1); PG8_BAR; PG8_SCHED;
            PG8_LDB(B0, 1, 0); PG8_LDB(B1, 1, 1); PG8_SCHED; PG8_LDA(At, 1, 0); PG8_STAGE(PG8_SA(0, 1), a2 + hstepA, voffA);
            PG8_WAIT_V(8); PG8_WAIT_L(0); PG8_BAR; PG8_MMA(0, 0, At, B0); PG8_MMA(0, 1, At, B1); PG8_BAR; PG8_SCHED;
            PG8_LDA(At, 1, 1); PG8_STAGE(PG8_SB(1, 0), b3, voffB); PG8_STAGE(PG8_SB(1, 1), b3 + hstepB, voffB); PG8_STAGE(PG8_SA(1, 0), a3, voffA);
            PG8_WAIT_V(8); PG8_WAIT_L(0); PG8_BAR; PG8_MMA(1, 0, At, B0); PG8_MMA(1, 1, At, B1); PG8_BAR; PG8_SCHED;
        }
        if (wr == 0) PG8_BAR;
        E(acc, cur, wr, wc, fr, fq);
        if (!has_next) break;
#pragma unroll
        for (int a = 0; a < 2; ++a)
#pragma unroll
            for (int b = 0; b < 2; ++b)
#pragma unroll
                for (int m = 0; m < 4; ++m)
#pragma unroll
                    for (int n = 0; n < 2; ++n) acc[a][b][m][n] = (f32x4){0.f, 0.f, 0.f, 0.f};
        cur = nxt; cA = nA; cB = nB; ++ui;
        if (wr == 1) PG8_BAR;
    }
    PG8_WAIT_V(0);
    PG8_BAR;
#undef PG8_SA
#undef PG8_SB
#undef PG8_STAGE
#undef PG8_LDA
#undef PG8_LDB
#undef PG8_MMA
#undef PG8_WAIT_V
#undef PG8_WAIT_L
#undef PG8_BAR
#undef PG8_SCHED
}
}
using pg8::Unit;

__device__ __forceinline__ float row_rstd(const float* st, int row) {
    const f32x4* p = (const f32x4*)(st + (size_t)row * 16);
    const f32x4 a = p[0], b = p[1], c = p[2], d = p[3];
    const float s = ((a.x + a.y) + (a.z + a.w)) + ((b.x + b.y) + (b.z + b.w)) + ((c.x + c.y) + (c.z + c.w)) + ((d.x + d.y) + (d.z + d.w));
    return rsqrtf(s * (1.0f / DM) + EPS);
}

struct EpiIn {
    static constexpr bool PERM = true;
    unsigned char* ws; const float* lb;
    __device__ __forceinline__ void operator()(const f32x4 (&acc)[2][2][4][2], const Unit& u, int wr, int wc, int fr, int fq) const {
        const float* st = (const float*)(ws + WS_ST1);
        const int cgp = u.pn >> 1;
        const int ccb = (u.pn & 1) * 256 + wc * 32 + 8 * fq;
        int dstg = -1;
        if (cgp == 0) dstg = 0; else if (cgp == 1) dstg = 3; else if (cgp == 3) dstg = 4; else if (cgp == 4) dstg = 5; else if (cgp == 5) dstg = 1;
        else if (cgp == 6) dstg = 6; else if (cgp == 8) dstg = 7; else if (cgp == 9) dstg = 2; else if (cgp == 10) dstg = 8;
#pragma unroll
        for (int ai = 0; ai < 2; ++ai)
#pragma unroll
            for (int m = 0; m < 4; ++m) {
                const int row = u.pm * 256 + ai * 128 + wr * 64 + m * 16 + fr;
                const float rs = row_rstd(st, row);
                const int bb = row >= LSEQ ? 1 : 0, t = row - bb * LSEQ;
#pragma unroll
                for (int bj = 0; bj < 2; ++bj) {
                    const int cc = ccb + bj * 128;
                    float v[8];
#pragma unroll
                    for (int e = 0; e < 4; ++e) { v[e] = acc[ai][bj][m][0][e] * rs; v[4 + e] = acc[ai][bj][m][1][e] * rs; }
                    if (cgp >= 11) {
#pragma unroll
                        for (int e = 0; e < 8; ++e) v[e] = sigmoidf_(v[e]);
                        bf16_t* dst = (bf16_t*)(ws + WS_GATE) + (size_t)row * DFF + (cgp - 11) * 512 + cc;
                        *(u32x4*)dst = __builtin_bit_cast(u32x4, pack8(v));
                    } else if (cgp == 2 || cgp == 7) {
                        bf16_t* dst = (bf16_t*)(ws + (cgp == 2 ? WS_IT : WS_VT)) + ((size_t)(bb * 512 + cc)) * LSEQ + t;
#pragma unroll
                        for (int e = 0; e < 8; ++e) dst[(size_t)e * LSEQ] = f2bf(v[e]);
                    } else {
                        if (cgp == 1) {
                            const bool valid = t >= NVALID0;
                            const f32x4 l0 = *(const f32x4*)(lb + cc), l1 = *(const f32x4*)(lb + cc + 4);
                            float lf[8];
#pragma unroll
                            for (int e = 0; e < 8; ++e) { const float lbv = e < 4 ? l0[e] : l1[e - 4]; const float sg = sigmoidf_(v[e]);
                                lf[e] = valid ? __logf(lbv + (1.0f - lbv) * sg) : 0.f; v[e] = valid ? (1.0f - lbv) * (1.0f - sg) : 0.f; }
                            float* ld = (float*)(ws + WS_LOGF) + (size_t)row * BW + cc;
                            *(f32x4*)ld = (f32x4){lf[0], lf[1], lf[2], lf[3]}; *(f32x4*)(ld + 4) = (f32x4){lf[4], lf[5], lf[6], lf[7]};
                        } else if (cgp == 3) {
#pragma unroll
                            for (int e = 0; e < 8; ++e) v[e] = sigmoidf_(v[e]);
                        } else if (cgp == 5) {
#pragma unroll
                            for (int e = 0; e < 8; ++e) v[e] *= 0.125f;
                        }
                        bf16_t* dst = (bf16_t*)(ws + WS_MIX + (size_t)dstg * SZ_G) + (size_t)row * BW + cc;
                        *(u32x4*)dst = __builtin_bit_cast(u32x4, pack8(v));
                    }
                }
            }
    }
};

struct EpiBranch {
    static constexpr bool PERM = false;
    unsigned char* ws;
    __device__ __forceinline__ void operator()(const f32x4 (&acc)[2][2][4][2], const Unit& u, int wr, int wc, int fr, int fq) const {
        const bf16_t* G = (const bf16_t*)(ws + WS_GATE); float* MF = (float*)(ws + WS_MIXEDF); bf16_t* MB = (bf16_t*)(ws + WS_MIXEDB);
        const int z = u.z;
#pragma unroll
        for (int ai = 0; ai < 2; ++ai)
#pragma unroll
            for (int m = 0; m < 4; ++m) {
                const int row = u.pm * 256 + ai * 128 + wr * 64 + m * 16 + fr;
#pragma unroll
                for (int bj = 0; bj < 2; ++bj)
#pragma unroll
                    for (int n = 0; n < 2; ++n) {
                        const int col = u.pn * 256 + bj * 128 + wc * 32 + n * 16 + 4 * fq;
                        const u32x2 gw = *(const u32x2*)(G + (size_t)row * DFF + z * DM + col);
                        f32x4 val = acc[ai][bj][m][n] * (f32x4){bflo(gw.x), bfhi(gw.x), bflo(gw.y), bfhi(gw.y)};
                        float* mp = MF + (size_t)row * DM + col;
                        if (z > 0) val += *(const f32x4*)mp;
                        if (z < 3) *(f32x4*)mp = val;
                        else { u32x2 w; w.x = cvt_pk_bf16(val[0], val[1]); w.y = cvt_pk_bf16(val[2], val[3]); *(u32x2*)(MB + (size_t)row * DM + col) = w; }
                    }
            }
    }
};

struct EpiResid {
    static constexpr bool PERM = false;
    unsigned char* ws; float* stat;
    __device__ __forceinline__ void operator()(const f32x4 (&acc)[2][2][4][2], const Unit& u, int wr, int wc, int fr, int fq) const {
        float* X = (float*)(ws + WS_X); bf16_t* XN = (bf16_t*)(ws + WS_XN);
#pragma unroll
        for (int ai = 0; ai < 2; ++ai)
#pragma unroll
            for (int m = 0; m < 4; ++m) {
                const int row = u.pm * 256 + ai * 128 + wr * 64 + m * 16 + fr;
                float ss = 0.f;
#pragma unroll
                for (int bj = 0; bj < 2; ++bj)
#pragma unroll
                    for (int n = 0; n < 2; ++n) {
                        const int col = u.pn * 256 + bj * 128 + wc * 32 + n * 16 + 4 * fq;
                        float* xp = X + (size_t)row * DM + col;
                        const f32x4 xv = *(const f32x4*)xp + acc[ai][bj][m][n];
                        *(f32x4*)xp = xv;
                        u32x2 w; w.x = cvt_pk_bf16(xv[0], xv[1]); w.y = cvt_pk_bf16(xv[2], xv[3]); *(u32x2*)(XN + (size_t)row * DM + col) = w;
                        ss += (xv[0] * xv[0] + xv[1] * xv[1]) + (xv[2] * xv[2] + xv[3] * xv[3]);
                    }
                ss += __shfl_xor(ss, 16); ss += __shfl_xor(ss, 32);
                if (fq == 0) stat[(size_t)row * 16 + u.pn * 4 + wc] = ss;
            }
    }
};

struct EpiUp {
    static constexpr bool PERM = true;
    unsigned char* ws;
    __device__ __forceinline__ void operator()(const f32x4 (&acc)[2][2][4][2], const Unit& u, int wr, int wc, int fr, int fq) const {
        const float* st = (const float*)(ws + WS_ST2); bf16_t* H = (bf16_t*)(ws + WS_H);
#pragma unroll
        for (int ai = 0; ai < 2; ++ai)
#pragma unroll
            for (int m = 0; m < 4; ++m) {
                const int row = u.pm * 256 + ai * 128 + wr * 64 + m * 16 + fr;
                const float rs = row_rstd(st, row);
#pragma unroll
                for (int bj = 0; bj < 2; ++bj) {
                    float v[8];
#pragma unroll
                    for (int e = 0; e < 4; ++e) { float a = fmaxf(acc[ai][bj][m][0][e] * rs, 0.f), b = fmaxf(acc[ai][bj][m][1][e] * rs, 0.f); v[e] = a * a; v[4 + e] = b * b; }
                    *(u32x4*)(H + (size_t)row * DFF + u.pn * 256 + bj * 128 + wc * 32 + 8 * fq) = __builtin_bit_cast(u32x4, pack8(v));
                }
            }
    }
};
__device__ __forceinline__ void transpose_item(const float* W, int K, int N, const float* ks, bf16_t* WT, LAS float* scr, int item, int lane) {
    const int nblk = N / 32, kb = item / nblk, nb = item % nblk, k0 = 64 * kb, n0 = 32 * nb;
#pragma unroll 8
    for (int i = 0; i < 32; ++i) { const int kk = 2 * i + (lane >> 5); float w = W[(size_t)(k0 + kk) * N + n0 + (lane & 31)]; if (ks) w *= ks[k0 + kk]; scr[kk * 33 + (lane & 31)] = w; }
    asm volatile("s_waitcnt lgkmcnt(0)" ::: "memory");
    const int c = lane & 7;
#pragma unroll
    for (int j = 0; j < 4; ++j) { const int n = (lane >> 3) + 8 * j; const LAS float* s = scr + (8 * c) * 33 + n;
        u32x4 o; o.x = cvt_pk_bf16(s[0 * 33], s[1 * 33]); o.y = cvt_pk_bf16(s[2 * 33], s[3 * 33]); o.z = cvt_pk_bf16(s[4 * 33], s[5 * 33]); o.w = cvt_pk_bf16(s[6 * 33], s[7 * 33]);
        *(u32x4*)(WT + (size_t)(n0 + n) * K + k0 + 8 * c) = o; }
    asm volatile("s_waitcnt lgkmcnt(0)" ::: "memory");
}
__device__ __forceinline__ void convert_layer(const Params& p, int l, LAS unsigned char* lds, int gw, int NGW, int wave, int lane) {
    LAS float* scr = (LAS float*)(lds + wave * 16384);
    unsigned char* ws = p.ws;
    constexpr int I_IN = (DM / 64) * (INC / 32), I_BR = (BW / 64) * (DM / 32), I_O = (DM / 64) * (DM / 32), I_UP = (DM / 64) * (DFF / 32), I_DN = (DFF / 64) * (DM / 32);
    constexpr int NIT = I_IN + 4 * I_BR + I_O + I_UP + I_DN;
    for (int it = gw; it < NIT; it += NGW) {
        int r = it;
        if (r < I_IN) { transpose_item(p.w_in + (size_t)l * DM * INC, DM, INC, p.norm1_g + l * DM, (bf16_t*)(ws + WS_WIN), scr, r, lane); continue; } r -= I_IN;
        if (r < 4 * I_BR) { const int n = r / I_BR; transpose_item(p.w_branch + ((size_t)l * 4 + n) * BW * DM, BW, DM, nullptr, (bf16_t*)(ws + WS_WBR) + (size_t)n * DM * BW, scr, r % I_BR, lane); continue; } r -= 4 * I_BR;
        if (r < I_O) { transpose_item(p.w_o + (size_t)l * DM * DM, DM, DM, nullptr, (bf16_t*)(ws + WS_WO), scr, r, lane); continue; } r -= I_O;
        if (r < I_UP) { transpose_item(p.w_up + (size_t)l * DM * DFF, DM, DFF, p.norm2_g + l * DM, (bf16_t*)(ws + WS_WUP), scr, r, lane); continue; } r -= I_UP;
        transpose_item(p.w_down + (size_t)l * DFF * DM, DFF, DM, nullptr, (bf16_t*)(ws + WS_WDN), scr, r, lane);
    }
}
__device__ __forceinline__ void prologue_misc(const Params& p, int gw, int NGW, int lane) {
    unsigned char* ws = p.ws;
    const int gt = gw * 64 + lane, NGT = NGW * 64;
    if (gt < BW) {
        float a[4], mx = -1e30f;
#pragma unroll
        for (int l = 0; l < 4; ++l) { a[l] = p.lb_logits[l * BW + gt]; mx = fmaxf(mx, a[l]); }
        float s = 0.f;
#pragma unroll
        for (int l = 0; l < 4; ++l) { a[l] = expf(a[l] - mx); s += a[l]; }
        float cum = 0.f; float* LB = (float*)(ws + WS_LB);
#pragma unroll
        for (int l = 0; l < 4; ++l) { LB[l * BW + gt] = cum; if (l < 3) cum += a[l + 1] / s; }
    }
    for (int i = gt; i < 4 * 4 * 128 * 128; i += NGT) {
        const int c = i & 127, d = (i >> 7) & 127, lg = i >> 14;
        ((bf16_t*)(ws + WS_PWT))[i] = f2bf(p.pool_w[((size_t)lg * 128 + c) * 128 + d] * p.pool_scale[lg * 128 + d]);
    }
    float* X = (float*)(ws + WS_X); bf16_t* XN = (bf16_t*)(ws + WS_XN); float* ST = (float*)(ws + WS_ST1);
    for (int row = gw; row < ROWS; row += NGW) {
        const int b = row >= LSEQ ? 1 : 0, t = row - b * LSEQ;
        const float* src = t < NVALID0 ? nullptr : (t < FRONT ? p.meta + (size_t)(t - NVALID0) * DM : p.x + ((size_t)b * SEQ + (t - FRONT)) * DM);
        float ss = 0.f;
#pragma unroll
        for (int j = 0; j < 4; ++j) {
            f32x4 v = src ? *((const f32x4*)src + 64 * j + lane) : (f32x4){0.f, 0.f, 0.f, 0.f};
            *((f32x4*)(X + (size_t)row * DM) + 64 * j + lane) = v;
            u32x2 w; w.x = cvt_pk_bf16(v[0], v[1]); w.y = cvt_pk_bf16(v[2], v[3]); *((u32x2*)(XN + (size_t)row * DM) + 64 * j + lane) = w;
            ss += (v[0] * v[0] + v[1] * v[1]) + (v[2] * v[2] + v[3] * v[3]);
        }
        ss = wave_sum(ss);
        if (lane < 16) ST[(size_t)row * 16 + lane] = lane == 0 ? ss : 0.f;
    }
}
__device__ __forceinline__ void final_norm(const Params& p, int gw, int NGW, int lane) {
    const float* X = (const float*)(p.ws + WS_X);
    for (int r = gw; r < BATCH * SEQ; r += NGW) {
        const int b = r / SEQ, s = r - b * SEQ; const size_t row = (size_t)b * LSEQ + FRONT + s;
        f32x4 v[4]; float ss = 0.f;
#pragma unroll
        for (int j = 0; j < 4; ++j) { v[j] = *((const f32x4*)(X + row * DM) + 64 * j + lane); ss += (v[j][0] * v[j][0] + v[j][1] * v[j][1]) + (v[j][2] * v[j][2] + v[j][3] * v[j][3]); }
        const float rs = rsqrtf(wave_sum(ss) * (1.0f / DM) + EPS);
#pragma unroll
        for (int j = 0; j < 4; ++j) { const f32x4 g = *((const f32x4*)p.final_g + 64 * j + lane); f32x4 ov = v[j] * rs * g;
#ifdef NANFIX
            for (int e = 0; e < 4; ++e) if (!(fabsf(ov[e]) < 1e30f)) ov[e] = 0.f;
#endif
            *((f32x4*)(p.out + (size_t)r * DM) + 64 * j + lane) = ov; }
    }
}

constexpr int PP = 136;
constexpr int BP = 132;

__device__ __forceinline__ void hgrn2_local(unsigned char* ws, LAS unsigned char* lds, int item, int tid, int wave, int lane) {
    const int h = item & 3, bc = item >> 2, b = bc / NCH, c = bc - b * NCH;
    const size_t row0 = (size_t)b * LSEQ + (size_t)c * 128;
    LAS float* Bs = (LAS float*)lds;
    LAS float* tot = (LAS float*)(lds + 128 * BP * 4);
    LAS bf16_t* KT = (LAS bf16_t*)(lds + 128 * BP * 4 + 2048);
    float* LF = (float*)(ws + WS_LOGF) + row0 * BW + h * 128;
    for (int i = tid; i < 128 * 32; i += NT) { const int s = i >> 5, c4 = (i & 31) * 4; *(LAS f32x4*)(Bs + s * BP + c4) = *(const f32x4*)(LF + (size_t)s * BW + c4); }
    __syncthreads();
    { const int k = tid & 127, seg = tid >> 7; float run = 0.f;
      for (int s = seg * 32; s < seg * 32 + 32; ++s) { run += Bs[s * BP + k]; Bs[s * BP + k] = run; }
      tot[seg * 128 + k] = run;
      __syncthreads();
      float off = 0.f;
      for (int q = 0; q < seg; ++q) off += tot[q * 128 + k];
      if (seg > 0) for (int s = seg * 32; s < seg * 32 + 32; ++s) Bs[s * BP + k] += off;
    }
    __syncthreads();
    for (int i = tid; i < 128 * 32; i += NT) { const int s = i >> 5, c4 = (i & 31) * 4; *(f32x4*)(LF + (size_t)s * BW + c4) = *(const LAS f32x4*)(Bs + s * BP + c4); }
    if (tid < 128) ((float*)(ws + WS_DEC))[(size_t)(bc * 4 + h) * 128 + tid] = __expf(Bs[127 * BP + tid]);
    const bf16_t* KK = (const bf16_t*)(ws + WS_MIX + 3 * SZ_G) + row0 * BW + h * 128;
    for (int i = tid; i < 128 * 16; i += NT) {
        const int s = i >> 4, k0 = (i & 15) * 8; float kv[8]; unpack8(*(const u32x4*)(KK + (size_t)s * BW + k0), kv);
#pragma unroll
        for (int e = 0; e < 8; ++e) KT[(k0 + e) * PP + s] = f2bf(kv[e] * __expf(Bs[127 * BP + k0 + e] - Bs[s * BP + k0 + e]));
    }
    __syncthreads();
    const int g = lane >> 4, l16 = lane & 15;
    f32x4 acc[8];
#pragma unroll
    for (int nb = 0; nb < 8; ++nb) acc[nb] = (f32x4){0.f, 0.f, 0.f, 0.f};
    const bf16_t* IT = (const bf16_t*)(ws + WS_IT) + ((size_t)(b * 512 + h * 128)) * LSEQ + c * 128;
#pragma unroll
    for (int ks = 0; ks < 4; ++ks) {
        const bf16x8 a = *(const LAS bf16x8*)(KT + (16 * wave + l16) * PP + 32 * ks + 8 * g);
#pragma unroll
        for (int nb = 0; nb < 8; ++nb) { const bf16x8 bf = *(const bf16x8*)(IT + (size_t)(16 * nb + l16) * LSEQ + 32 * ks + 8 * g); acc[nb] = MFMA16(a, bf, acc[nb]); }
    }
    float* DS = (float*)(ws + WS_DS) + (size_t)(bc * 4 + h) * 16384;
#pragma unroll
    for (int nb = 0; nb < 8; ++nb) *(f32x4*)(DS + (size_t)(16 * nb + l16) * 128 + 16 * wave + 4 * g) = acc[nb];
    __syncthreads();
}

__device__ __forceinline__ void hgrn2_scan(unsigned char* ws, int gt, int NGT) {
    const float* DS = (const float*)(ws + WS_DS); const float* DEC = (const float*)(ws + WS_DEC); bf16_t* SP = (bf16_t*)(ws + WS_SPREV);
    for (int e = gt; e < 8 * 16384; e += NGT) {
        const int bh = e >> 14, vk = e & 16383, b = bh >> 2, h = bh & 3, k = vk & 127;
        float S = 0.f;
#pragma unroll 5
        for (int c = 0; c < NCH; ++c) {
            const size_t ci = (size_t)((b * NCH + c) * 4 + h);
            SP[ci * 16384 + vk] = f2bf(S);
            S = DEC[ci * 128 + k] * S + DS[ci * 16384 + vk];
        }
    }
}

__device__ __forceinline__ void hgrn2_out(unsigned char* ws, const float* ng, LAS unsigned char* lds, int item, int tid, int wave, int lane) {
    const int h = item & 3, bc = item >> 2, b = bc / NCH, c = bc - b * NCH;
    const size_t row0 = (size_t)b * LSEQ + (size_t)c * 128;
    LAS bf16_t* Pm = (LAS bf16_t*)lds;
    const float* Bc = (const float*)(ws + WS_LOGF) + row0 * BW + h * 128;
    bf16_t* Q = (bf16_t*)(ws + WS_MIX) + row0 * BW + h * 128;
    const bf16_t* KK = (const bf16_t*)(ws + WS_MIX + 3 * SZ_G) + row0 * BW + h * 128;
    const bf16_t* SG = (const bf16_t*)(ws + WS_MIX + 4 * SZ_G) + row0 * BW + h * 128;
    const int g = lane >> 4, l16 = lane & 15;
    {
        const int j = wave;
        float rj[4][8];
#pragma unroll
        for (int ks = 0; ks < 4; ++ks) {
            f32x4 r0 = (f32x4){0.f, 0.f, 0.f, 0.f}, r1 = r0;
            if (j > 0) { const float* rp = Bc + (size_t)(16 * j - 1) * BW + 32 * ks + 8 * g; r0 = *(const f32x4*)rp; r1 = *(const f32x4*)(rp + 4); }
#pragma unroll
            for (int e = 0; e < 4; ++e) { rj[ks][e] = r0[e]; rj[ks][4 + e] = r1[e]; }
        }
        bf16x8 kf[4];
        { const int s = 16 * j + l16;
#pragma unroll
          for (int ks = 0; ks < 4; ++ks) {
              const int k0 = 32 * ks + 8 * g; float kv[8]; unpack8(*(const u32x4*)(KK + (size_t)s * BW + k0), kv);
              const f32x4 b0 = *(const f32x4*)(Bc + (size_t)s * BW + k0), b1 = *(const f32x4*)(Bc + (size_t)s * BW + k0 + 4);
#pragma unroll
              for (int e = 0; e < 8; ++e) kv[e] *= __expf(fminf(rj[ks][e] - (e < 4 ? b0[e] : b1[e - 4]), 80.f));
              kf[ks] = pack8(kv);
          } }
        for (int i = j; i < 8; ++i) {
            const int t = 16 * i + l16;
            f32x4 sc = (f32x4){0.f, 0.f, 0.f, 0.f};
#pragma unroll
            for (int ks = 0; ks < 4; ++ks) {
                const int k0 = 32 * ks + 8 * g; float qv[8]; unpack8(*(const u32x4*)(Q + (size_t)t * BW + k0), qv);
                const f32x4 b0 = *(const f32x4*)(Bc + (size_t)t * BW + k0), b1 = *(const f32x4*)(Bc + (size_t)t * BW + k0 + 4);
#pragma unroll
                for (int e = 0; e < 8; ++e) qv[e] *= __expf((e < 4 ? b0[e] : b1[e - 4]) - rj[ks][e]);
                sc = MFMA16(pack8(qv), kf[ks], sc);
            }
#pragma unroll
            for (int r = 0; r < 4; ++r) { float v = sc[r]; if (i == j && l16 > 4 * g + r) v = 0.f; Pm[(16 * i + 4 * g + r) * PP + 16 * j + l16] = f2bf(v); }
        }
        for (int i = 0; i < j; ++i)
#pragma unroll
            for (int r = 0; r < 4; ++r) Pm[(16 * i + 4 * g + r) * PP + 16 * j + l16] = 0;
    }
    __syncthreads();
    f32x4 o[8];
#pragma unroll
    for (int nb = 0; nb < 8; ++nb) o[nb] = (f32x4){0.f, 0.f, 0.f, 0.f};
    const bf16_t* IT = (const bf16_t*)(ws + WS_IT) + ((size_t)(b * 512 + h * 128)) * LSEQ + c * 128;
    const int nks = (16 * wave + 15) / 32 + 1;
    for (int ks = 0; ks < nks; ++ks) {
        const bf16x8 a = *(const LAS bf16x8*)(Pm + (16 * wave + l16) * PP + 32 * ks + 8 * g);
#pragma unroll
        for (int nb = 0; nb < 8; ++nb) { const bf16x8 bf = *(const bf16x8*)(IT + (size_t)(16 * nb + l16) * LSEQ + 32 * ks + 8 * g); o[nb] = MFMA16(a, bf, o[nb]); }
    }
    const bf16_t* SP = (const bf16_t*)(ws + WS_SPREV) + (size_t)(bc * 4 + h) * 16384;
    { const int t = 16 * wave + l16;
#pragma unroll
      for (int ks = 0; ks < 4; ++ks) {
          const int k0 = 32 * ks + 8 * g; float qv[8]; unpack8(*(const u32x4*)(Q + (size_t)t * BW + k0), qv);
          const f32x4 b0 = *(const f32x4*)(Bc + (size_t)t * BW + k0), b1 = *(const f32x4*)(Bc + (size_t)t * BW + k0 + 4);
#pragma unroll
          for (int e = 0; e < 8; ++e) qv[e] *= __expf(e < 4 ? b0[e] : b1[e - 4]);
          const bf16x8 a = pack8(qv);
#pragma unroll
          for (int nb = 0; nb < 8; ++nb) { const bf16x8 bf = *(const bf16x8*)(SP + (size_t)(16 * nb + l16) * 128 + k0); o[nb] = MFMA16(a, bf, o[nb]); }
      } }
    float rs[4];
#pragma unroll
    for (int r = 0; r < 4; ++r) { float ss = 0.f;
#pragma unroll
        for (int nb = 0; nb < 8; ++nb) ss += o[nb][r] * o[nb][r];
        ss += __shfl_xor(ss, 1); ss += __shfl_xor(ss, 2); ss += __shfl_xor(ss, 4); ss += __shfl_xor(ss, 8);
        rs[r] = rsqrtf(ss * (1.0f / 128.f) + EPS); }
    __syncthreads();
#pragma unroll
    for (int nb = 0; nb < 8; ++nb) { const int v = 16 * nb + l16; const float gn = ng[h * 128 + v];
#pragma unroll
        for (int r = 0; r < 4; ++r) { const int t = 16 * wave + 4 * g + r; Q[(size_t)t * BW + v] = f2bf(o[nb][r] * rs[r] * gn * bf2f(SG[(size_t)t * BW + v])); } }
}

__device__ __forceinline__ void pool_item(unsigned char* ws, int l, int item, int wave, int lane) {
    const int grp = item & 3, ch = item >> 2, b = ch / NCH;
    const int g = lane >> 4, l16 = lane & 15;
    const int row = ch * 128 + 16 * wave + l16, t = row - b * LSEQ, wnd = 2 << grp;
    const bf16_t* PV = (const bf16_t*)(ws + WS_MIX + 5 * SZ_G);
    const float invn = 1.0f / (float)max(min(wnd, t - (NVALID0 - 1)), 1);
    bf16x8 af[4];
#pragma unroll
    for (int ks = 0; ks < 4; ++ks) {
        const int c0 = grp * 128 + 32 * ks + 8 * g; float sum[8], v0[8];
        unpack8(*(const u32x4*)(PV + (size_t)row * BW + c0), v0);
#pragma unroll
        for (int e = 0; e < 8; ++e) sum[e] = v0[e];
        for (int i = 1; i < wnd; ++i) if (t - i >= 0) { float vv[8]; unpack8(*(const u32x4*)(PV + (size_t)(row - i) * BW + c0), vv);
#pragma unroll
            for (int e = 0; e < 8; ++e) sum[e] += vv[e]; }
#pragma unroll
        for (int e = 0; e < 8; ++e) sum[e] = sum[e] * invn - v0[e];
        af[ks] = pack8(sum);
    }
    const bf16_t* PW = (const bf16_t*)(ws + WS_PWT) + (size_t)(l * 4 + grp) * 16384;
    bf16_t* PO = (bf16_t*)(ws + WS_POOLO);
#pragma unroll
    for (int nb = 0; nb < 8; ++nb) {
        f32x4 o = (f32x4){0.f, 0.f, 0.f, 0.f};
#pragma unroll
        for (int ks = 0; ks < 4; ++ks) o = MFMA16(af[ks], *(const bf16x8*)(PW + (size_t)(16 * nb + l16) * 128 + 32 * ks + 8 * g), o);
#pragma unroll
        for (int r = 0; r < 4; ++r) PO[(size_t)(ch * 128 + 16 * wave + 4 * g + r) * BW + grp * 128 + 16 * nb + l16] = f2bf(o[r]);
    }
}

__device__ __forceinline__ void conv_item(unsigned char* ws, const float* cw, int ch, int tid) {
    const int b = ch / NCH;
    const bf16_t* Hh = (const bf16_t*)(ws + WS_MIX + 7 * SZ_G); const bf16_t* Cc = (const bf16_t*)(ws + WS_MIX + 8 * SZ_G); bf16_t* Bb = (bf16_t*)(ws + WS_MIX + 2 * SZ_G);
    for (int i = tid; i < 128 * 64; i += NT) {
        const int row = ch * 128 + (i >> 6), c0 = (i & 63) * 8, t = row - b * LSEQ;
        float y[8];
#pragma unroll
        for (int e = 0; e < 8; ++e) y[e] = 0.f;
#pragma unroll
        for (int j = 0; j < 3; ++j) { const int d = 2 - j; if (t - d >= 0) {
            float hv[8], cv[8]; unpack8(*(const u32x4*)(Hh + (size_t)(row - d) * BW + c0), hv); unpack8(*(const u32x4*)(Cc + (size_t)(row - d) * BW + c0), cv);
            const f32x4 w0 = *(const f32x4*)(cw + j * BW + c0), w1 = *(const f32x4*)(cw + j * BW + c0 + 4);
#pragma unroll
            for (int e = 0; e < 8; ++e) y[e] += (e < 4 ? w0[e] : w1[e - 4]) * (cv[e] * hv[e]); } }
        float bv[8]; unpack8(*(const u32x4*)(Bb + (size_t)row * BW + c0), bv);
#pragma unroll
        for (int e = 0; e < 8; ++e) y[e] *= bv[e];
        *(u32x4*)(Bb + (size_t)row * BW + c0) = __builtin_bit_cast(u32x4, pack8(y));
    }
}

__device__ __forceinline__ void attn_item(unsigned char* ws, LAS unsigned char* lds, int item, int wave, int lane) {
    const int qb = item % NCH, bh = item / NCH, h = bh & 7, b = bh >> 3;
    const int t0 = qb * 128 + 16 * wave;
    if (t0 < NVALID0) return;
    const int g = lane >> 4, l16 = lane & 15;
    bf16_t* Q = (bf16_t*)(ws + WS_MIX + 1 * SZ_G) + (size_t)b * LSEQ * BW + h * 64;
    const bf16_t* Kk = (const bf16_t*)(ws + WS_MIX + 6 * SZ_G) + (size_t)b * LSEQ * BW + h * 64;
    const bf16_t* VT = (const bf16_t*)(ws + WS_VT) + ((size_t)(b * 512 + h * 64)) * LSEQ;
    LAS bf16_t* PW = (LAS bf16_t*)(lds + wave * 4096);
    const bf16x8 qa0 = *(const bf16x8*)(Q + (size_t)(t0 + l16) * BW + 8 * g), qa1 = *(const bf16x8*)(Q + (size_t)(t0 + l16) * BW + 32 + 8 * g);
    float R[4] = {0.f, 0.f, 0.f, 0.f};
    f32x4 o[4];
#pragma unroll
    for (int nb = 0; nb < 4; ++nb) o[nb] = (f32x4){0.f, 0.f, 0.f, 0.f};
    for (int kb = (t0 + 15) >> 6; kb >= 1; --kb) {
        f32x4 sc[4];
#pragma unroll
        for (int nb = 0; nb < 4; ++nb) {
            const bf16_t* kp = Kk + (size_t)(64 * kb + 16 * nb + l16) * BW + 8 * g;
            sc[nb] = MFMA16(qa0, *(const bf16x8*)kp, ((f32x4){0.f, 0.f, 0.f, 0.f}));
            sc[nb] = MFMA16(qa1, *(const bf16x8*)(kp + 32), sc[nb]);
        }
        float lk[4][4], ls[4][4], tot[4][4];
#pragma unroll
        for (int nb = 0; nb < 4; ++nb)
#pragma unroll
            for (int r = 0; r < 4; ++r) {
                const int s = 64 * kb + 16 * nb + l16, t = t0 + 4 * g + r; const bool valid = (s < t) && (s >= NVALID0);
                const float z = sc[nb][r]; const float sp = fmaxf(z, 0.f) + __logf(1.0f + __expf(-fabsf(z)));
                lk[nb][r] = valid ? -sp : 0.f; ls[nb][r] = valid ? (z - sp) : -1e30f;
                float inc = lk[nb][r];
#pragma unroll
                for (int d = 1; d < 16; d <<= 1) { const float tmp = __shfl_down(inc, d, 16); inc += (l16 + d < 16) ? tmp : 0.f; }
                tot[nb][r] = __shfl(inc, 0, 16);
                lk[nb][r] = inc - lk[nb][r];
            }
#pragma unroll
        for (int r = 0; r < 4; ++r) {
            float off = R[r];
#pragma unroll
            for (int nb = 3; nb >= 0; --nb) {
                const float a = __expf(ls[nb][r] + lk[nb][r] + off);
                PW[(4 * g + r) * 72 + 16 * nb + l16] = f2bf(a);
                off += tot[nb][r];
            }
            R[r] = off;
        }
        asm volatile("s_waitcnt lgkmcnt(0)" ::: "memory");
#pragma unroll
        for (int ks = 0; ks < 2; ++ks) {
            const bf16x8 a = *(const LAS bf16x8*)(PW + l16 * 72 + 32 * ks + 8 * g);
#pragma unroll
            for (int nb = 0; nb < 4; ++nb) o[nb] = MFMA16(a, *(const bf16x8*)(VT + (size_t)(16 * nb + l16) * LSEQ + 64 * kb + 32 * ks + 8 * g), o[nb]);
        }
        asm volatile("s_waitcnt lgkmcnt(0)" ::: "memory");
        float mx = fmaxf(fmaxf(R[0], R[1]), fmaxf(R[2], R[3]));
        mx = fmaxf(mx, __shfl_xor(mx, 16)); mx = fmaxf(mx, __shfl_xor(mx, 32));
        if (mx < -105.f) break;
    }
#pragma unroll
    for (int nb = 0; nb < 4; ++nb)
#pragma unroll
        for (int r = 0; r < 4; ++r) Q[(size_t)(t0 + 4 * g + r) * BW + 16 * nb + l16] = f2bf(o[nb][r]);
}
constexpr int N_ATT = 16 * NCH, N_HGL = 2 * NCH * 4, N_POOL = 2 * NCH * 4, N_CONV = 2 * NCH;
__device__ __forceinline__ unsigned char* launder(unsigned char* q) { asm volatile("" : "+s"(q)); return q; }
#define PH_COMMON \
    int tid_ = threadIdx.x; asm volatile("" : "+v"(tid_)); int G_ = gridDim.x, bid_ = blockIdx.x; asm volatile("" : "+s"(G_), "+s"(bid_)); \
    const int tid = tid_, lane = tid & 63, wave = __builtin_amdgcn_readfirstlane(tid >> 6); \
    const int G = G_, bid = bid_, gw = bid * NWAVES + wave, NGW = G * NWAVES; unsigned char* ws = launder(p.ws); (void)lane; (void)gw; (void)NGW; (void)tid; (void)ws;

__device__ __forceinline__ void ph_pro(const Params& p, LAS unsigned char* lds, int l) { PH_COMMON
    if (l == 0) prologue_misc(p, gw, NGW, lane);
    convert_layer(p, l, lds, gw, NGW, wave, lane); }
__device__ __forceinline__ void ph_p1(const Params& p, LAS unsigned char* lds, int l) { PH_COMMON
    pg8::SchedPlain S; S.T.init(ROWS, INC); S.G = G; S.c = bid; S.A = (const char*)(ws + WS_XN); S.B = (const char*)(ws + WS_WIN); S.astep = (size_t)256 * DM * 2; S.bstep = (size_t)256 * DM * 2;
    EpiIn E{ws, (const float*)(ws + WS_LB) + l * BW};
    pg8::gemm_phase(lds, tid, DM, DM, DM, S, E); }
__device__ __forceinline__ void ph_p2a(const Params& p, LAS unsigned char* lds, int l) { PH_COMMON
    for (int it = bid; it < N_ATT + N_HGL + N_POOL + N_CONV; it += G) {
        __syncthreads();
        if (it < N_ATT) attn_item(ws, lds, it, wave, lane);
        else if (it < N_ATT + N_HGL) hgrn2_local(ws, lds, it - N_ATT, tid, wave, lane);
        else if (it < N_ATT + N_HGL + N_POOL) pool_item(ws, l, it - N_ATT - N_HGL, wave, lane);
        else conv_item(ws, p.conv_w + (size_t)l * 3 * BW, it - N_ATT - N_HGL - N_POOL, tid);
    } }
__device__ __forceinline__ void ph_p2b(const Params& p, LAS unsigned char* lds, int l) { PH_COMMON
    hgrn2_scan(ws, gw * 64 + lane, NGW * 64); }
__device__ __forceinline__ void ph_p2c(const Params& p, LAS unsigned char* lds, int l) { PH_COMMON
    for (int it = bid; it < N_HGL; it += G) hgrn2_out(ws, p.hg_norm_g + l * BW, lds, it, tid, wave, lane); }
__device__ __forceinline__ void ph_p3(const Params& p, LAS unsigned char* lds, int l) { PH_COMMON
    pg8::SchedBranch S; S.T.init(ROWS, DM); S.G = G; S.c = bid;
    S.A0 = (const char*)(ws + WS_MIX); S.A1 = (const char*)(ws + WS_POOLO); S.A2 = (const char*)(ws + WS_MIX + SZ_G); S.A3 = (const char*)(ws + WS_MIX + 2 * SZ_G);
    S.B = (const char*)(ws + WS_WBR); S.astep = (size_t)256 * BW * 2; S.bstep = (size_t)256 * BW * 2; S.bz = (size_t)DM * BW * 2;
    EpiBranch E{ws};
    pg8::gemm_phase(lds, tid, BW, BW, BW, S, E); }
__device__ __forceinline__ void ph_p4(const Params& p, LAS unsigned char* lds, int l) { PH_COMMON
    pg8::SchedPlain S; S.T.init(ROWS, DM); S.G = G; S.c = bid; S.A = (const char*)(ws + WS_MIXEDB); S.B = (const char*)(ws + WS_WO); S.astep = (size_t)256 * DM * 2; S.bstep = (size_t)256 * DM * 2;
    EpiResid E{ws, (float*)(ws + WS_ST2)};
    pg8::gemm_phase(lds, tid, DM, DM, DM, S, E); }
__device__ __forceinline__ void ph_p5(const Params& p, LAS unsigned char* lds, int l) { PH_COMMON
    pg8::SchedPlain S; S.T.init(ROWS, DFF); S.G = G; S.c = bid; S.A = (const char*)(ws + WS_XN); S.B = (const char*)(ws + WS_WUP); S.astep = (size_t)256 * DM * 2; S.bstep = (size_t)256 * DM * 2;
    EpiUp E{ws};
    pg8::gemm_phase(lds, tid, DM, DM, DM, S, E); }
__device__ __forceinline__ void ph_p6(const Params& p, LAS unsigned char* lds, int l) { PH_COMMON
    pg8::SchedPlain S; S.T.init(ROWS, DM); S.G = G; S.c = bid; S.A = (const char*)(ws + WS_H); S.B = (const char*)(ws + WS_WDN); S.astep = (size_t)256 * DFF * 2; S.bstep = (size_t)256 * DFF * 2;
    EpiResid E{ws, (float*)(ws + WS_ST1)};
    pg8::gemm_phase(lds, tid, DFF, DFF, DFF, S, E); }
__device__ __forceinline__ void ph_fin(const Params& p, LAS unsigned char* lds, int l) { PH_COMMON
    final_norm(p, gw, NGW, lane); }

#ifndef MEGA
#define MEGA 1
#endif
#ifdef DIAG
__global__ void k_chk(const unsigned char* base, size_t nbytes, int isf32, int code, unsigned* flag) {
    const size_t n = nbytes / 4; const unsigned* w = (const unsigned*)base; bool bad = false;
    for (size_t i = (size_t)blockIdx.x * blockDim.x + threadIdx.x; i < n; i += (size_t)gridDim.x * blockDim.x) {
        const unsigned u = w[i];
        if (isf32) bad |= (u & 0x7F800000u) == 0x7F800000u;
        else bad |= ((u & 0x7F80u) == 0x7F80u) || ((u & 0x7F800000u) == 0x7F800000u);
    }
    if (bad) atomicMin(flag, (unsigned)code);
}
__global__ void k_flaginit(unsigned* flag) { if (threadIdx.x == 0 && blockIdx.x == 0) *flag = 99u; }
__global__ void k_flagout(const unsigned* flag, float* out, size_t n) {
    const unsigned f = *flag; if (f == 99u) return;
    for (size_t i = (size_t)blockIdx.x * blockDim.x + threadIdx.x; i < n; i += (size_t)gridDim.x * blockDim.x) out[i] = (float)f;
}

#endif
#if MEGA
__global__ void __launch_bounds__(NT, 2) fwd_megakernel(Params p) {
    extern __shared__ __attribute__((aligned(16))) unsigned char lds_raw[];
    LAS unsigned char* lds = (LAS unsigned char*)lds_raw;
    cg::grid_group grid = cg::this_grid();
#pragma unroll 1
    for (int ph = 0; ph < 1 + DEPTH * 9; ++ph) {
        const int l = ph == 0 ? 0 : (ph - 1) / 9, k = ph == 0 ? 0 : (ph - 1) % 9;
        if (ph == 0) ph_pro(p, lds, 0);
        else if (k == 0) ph_p1(p, lds, l);
        else if (k == 1) ph_p2a(p, lds, l);
        else if (k == 2) ph_p2b(p, lds, l);
        else if (k == 3) ph_p2c(p, lds, l);
        else if (k == 4) ph_p3(p, lds, l);
        else if (k == 5) ph_p4(p, lds, l);
        else if (k == 6) ph_p5(p, lds, l);
        else if (k == 7) ph_p6(p, lds, l);
        else { if (l + 1 < DEPTH) ph_pro(p, lds, l + 1); }
        grid.sync();
    }
    ph_fin(p, lds, 0);
}
#else
#define MKK(NAME, FN) __global__ void __launch_bounds__(NT, 2) NAME(Params p, int l) { \
    extern __shared__ __attribute__((aligned(16))) unsigned char lds_raw[]; FN(p, (LAS unsigned char*)lds_raw, l); }
MKK(k_pro, ph_pro) MKK(k_p1, ph_p1) MKK(k_p2a, ph_p2a) MKK(k_p2b, ph_p2b) MKK(k_p2c, ph_p2c) MKK(k_p3, ph_p3) MKK(k_p4, ph_p4) MKK(k_p5, ph_p5) MKK(k_p6, ph_p6) MKK(k_fin, ph_fin)
__device__ __forceinline__ void ph_poolonly(const Params& p, LAS unsigned char* lds, int l) { PH_COMMON
    for (int it = bid; it < N_POOL; it += G) pool_item(ws, l, it, wave, lane); }
MKK(k_poolonly, ph_poolonly)
#endif

extern "C" void kernel_launch(void* const* d_in, const int* in_sizes, int n_in, void* d_out, int out_size, void* d_ws, size_t ws_size, hipStream_t stream) {
    static int grid = 0;
    if (grid == 0) {
        int dev = 0, cus = 0;
        (void)hipGetDevice(&dev); (void)hipDeviceGetAttribute(&cus, hipDeviceAttributeMultiprocessorCount, dev);
#if MEGA
        int per = 0;
        (void)hipFuncSetAttribute((const void*)fwd_megakernel, hipFuncAttributeMaxDynamicSharedMemorySize, LDS_BYTES);
        (void)hipOccupancyMaxActiveBlocksPerMultiprocessor(&per, (const void*)fwd_megakernel, NT, LDS_BYTES);
        if (per < 1) per = 1;
        grid = cus * per;
#else
        const void* ks[] = {(const void*)k_pro, (const void*)k_p1, (const void*)k_p2a, (const void*)k_p2b, (const void*)k_p2c, (const void*)k_p3, (const void*)k_p4, (const void*)k_p5, (const void*)k_p6, (const void*)k_fin};
        for (int i = 0; i < 10; ++i) (void)hipFuncSetAttribute(ks[i], hipFuncAttributeMaxDynamicSharedMemorySize, LDS_BYTES);
        grid = cus;
#endif
        if (n_in != 15 || ws_size < WS_END) { fprintf(stderr, "kernel_launch: unexpected n_in %d / ws %zu (need %zu)\n", n_in, ws_size, (size_t)WS_END); }
    }
    Params p{};
    p.x = (const float*)d_in[0]; p.meta = (const float*)d_in[1]; p.lb_logits = (const float*)d_in[2]; p.norm1_g = (const float*)d_in[3]; p.w_in = (const float*)d_in[4];
    p.hg_norm_g = (const float*)d_in[5]; p.pool_w = (const float*)d_in[6]; p.pool_scale = (const float*)d_in[7]; p.conv_w = (const float*)d_in[8]; p.w_branch = (const float*)d_in[9];
    p.w_o = (const float*)d_in[10]; p.norm2_g = (const float*)d_in[11]; p.w_up = (const float*)d_in[12]; p.w_down = (const float*)d_in[13]; p.final_g = (const float*)d_in[14];
    p.out = (float*)d_out; p.ws = (unsigned char*)d_ws;
#if MEGA
    void* args[] = {&p};
    hipError_t e = hipLaunchCooperativeKernel((void*)fwd_megakernel, dim3(grid), dim3(NT), args, LDS_BYTES, stream);
    if (e != hipSuccess) fprintf(stderr, "cooperative launch failed: %s (grid %d)\n", hipGetErrorString(e), grid);
#else
#define LK(K, L) hipLaunchKernelGGL(K, dim3(grid), dim3(NT), LDS_BYTES, stream, p, (int)(L))
#ifdef DIAG
    unsigned char* W = (unsigned char*)d_ws; unsigned* flag = (unsigned*)(W + WS_END + 4096);
#define CHK(off, bytes, f32, code) hipLaunchKernelGGL(k_chk, dim3(1024), dim3(256), 0, stream, (const unsigned char*)(W + (off)), (size_t)(bytes), (int)(f32), (int)(code), flag)
    hipLaunchKernelGGL(k_flaginit, dim3(1), dim3(64), 0, stream, flag);
    LK(k_pro, 0);
    CHK(WS_X, (size_t)ROWS * DM * 4, 1, 1); CHK(WS_XN, (size_t)ROWS * DM * 2, 0, 1); CHK(WS_WIN, WS_X - WS_WIN, 0, 1); CHK(WS_LB, WS_DEC, 1, 1); CHK(WS_ST1, (size_t)ROWS * 64, 1, 1);
    LK(k_p1, 0);
    CHK(WS_MIX, 9 * SZ_G, 0, 2); CHK(WS_IT, 2 * SZ_G, 0, 3); CHK(WS_GATE, (size_t)ROWS * DFF * 2, 0, 4); CHK(WS_LOGF, (size_t)ROWS * BW * 4, 1, 5);
    CHK(WS_PWT, 4 * 4 * 128 * 128 * 2, 0, 1);
    LK(k_poolonly, 0);
    CHK(WS_POOLO, SZ_G, 0, 6);
    LK(k_p2a, 0);
    CHK(WS_POOLO, SZ_G, 0, 16); CHK(WS_DS, (size_t)ROWS * BW * 4, 1, 7); CHK(WS_LOGF, (size_t)ROWS * BW * 4, 1, 8); CHK(WS_MIX + SZ_G, 2 * SZ_G, 0, 9);
    LK(k_p2b, 0);
    CHK(WS_SPREV, SZ_G, 0, 10);
    LK(k_p2c, 0);
    CHK(WS_MIX, SZ_G, 0, 11);
    LK(k_p3, 0);
    CHK(WS_MIXEDB, 2 * SZ_G, 0, 12);
    LK(k_p4, 0);
    CHK(WS_X, (size_t)ROWS * DM * 4, 1, 13);
    LK(k_p5, 0);
    CHK(WS_H, (size_t)ROWS * DFF * 2, 0, 14);
    LK(k_p6, 0);
    CHK(WS_X, (size_t)ROWS * DM * 4, 1, 15);
    LK(k_fin, 0);
    hipLaunchKernelGGL(k_flagout, dim3(1024), dim3(256), 0, stream, (const unsigned*)flag, (float*)d_out, (size_t)BATCH * SEQ * DM);
#else
    LK(k_pro, 0);
    for (int l = 0; l < DEPTH; ++l) {
        if (l > 0) LK(k_pro, l);
        LK(k_p1, l); LK(k_p2a, l); LK(k_p2b, l); LK(k_p2c, l); LK(k_p3, l); LK(k_p4, l); LK(k_p5, l); LK(k_p6, l);
    }
    LK(k_fin, 0);
#endif
#endif
}
```

```cpp
#define MEGA 1
#include <hip/hip_runtime.h>
#include <hip/hip_cooperative_groups.h>
#include <cstdio>
#include <cstdint>
namespace cg = cooperative_groups;

#define LAS __attribute__((address_space(3)))
typedef unsigned short bf16_t;
typedef short bf16x8 __attribute__((ext_vector_type(8)));
typedef float f32x4 __attribute__((ext_vector_type(4)));
typedef float f32x2 __attribute__((ext_vector_type(2)));
typedef unsigned u32x4 __attribute__((ext_vector_type(4)));
typedef unsigned u32x2 __attribute__((ext_vector_type(2)));

constexpr int DM = 1024, BATCH = 2, SEQ = 8192, DEPTH = 4, FRONT = 128, NVALID0 = 112, LSEQ = 8320, ROWS = BATCH * LSEQ;
constexpr int BW = 512, INC = 9728, DFF = 4096, NCH = 65;
constexpr float EPS = 1e-6f;
constexpr int NT = 512, NWAVES = 8;
constexpr int MROWS = BATCH * SEQ;

constexpr size_t al(size_t x) { return (x + 4095) & ~(size_t)4095; }
constexpr size_t SZ_G = (size_t)ROWS * BW * 2;
constexpr size_t WS_LB = 0;
constexpr size_t WS_PWT = al(WS_LB + 4 * 512 * 4);
constexpr size_t WS_DEC = al(WS_PWT + 4 * 4 * 128 * 128 * 2);
constexpr size_t WS_ST1 = al(WS_DEC + 2 * 65 * 4 * 128 * 4);
constexpr size_t WS_ST2 = al(WS_ST1 + (size_t)ROWS * 16 * 4);
constexpr size_t WS_WIN = al(WS_ST2 + (size_t)ROWS * 16 * 4);
constexpr size_t WS_WBR = al(WS_WIN + (size_t)INC * DM * 2);
constexpr size_t WS_WO = al(WS_WBR + (size_t)4 * DM * BW * 2);
constexpr size_t WS_WUP = al(WS_WO + (size_t)DM * DM * 2);
constexpr size_t WS_WDN = al(WS_WUP + (size_t)DFF * DM * 2);
constexpr size_t WS_X = al(WS_WDN + (size_t)DFF * DM * 2);
constexpr size_t WS_XN = al(WS_X + (size_t)ROWS * DM * 4);
constexpr size_t WS_MIX = al(WS_XN + (size_t)ROWS * DM * 2);
constexpr size_t WS_MIXEDB = WS_MIX + 3 * SZ_G;
constexpr size_t WS_POOLO = al(WS_MIX + 9 * SZ_G);
constexpr size_t WS_IT = al(WS_POOLO + SZ_G);
constexpr size_t WS_VT = al(WS_IT + SZ_G);
constexpr size_t WS_GATE = al(WS_VT + SZ_G);
constexpr size_t WS_H = WS_GATE;
constexpr size_t WS_LOGF = al(WS_GATE + (size_t)ROWS * DFF * 2);
constexpr size_t WS_DS = WS_LOGF + (size_t)ROWS * BW * 4;
constexpr size_t WS_MIXEDF = WS_LOGF;
constexpr size_t WS_SPREV = al(WS_DS + (size_t)ROWS * BW * 4);
constexpr size_t WS_CTL = al(WS_SPREV + SZ_G);
constexpr size_t WS_END = WS_CTL + 16384;
static_assert(WS_DS + (size_t)ROWS * BW * 4 == WS_MIXEDF + (size_t)ROWS * DM * 4, "MIXEDF overlay");

constexpr int LDS_BYTES = 147456;

typedef __bf16 bf16x2_t __attribute__((ext_vector_type(2)));
__device__ __forceinline__ unsigned cvt_pk_bf16(float lo, float hi) { const f32x2 v = {lo, hi}; return __builtin_bit_cast(unsigned, __builtin_convertvector(v, bf16x2_t)); }
__device__ __forceinline__ float bflo(unsigned w) { return __uint_as_float(w << 16); }
__device__ __forceinline__ float bfhi(unsigned w) { return __uint_as_float(w & 0xffff0000u); }
__device__ __forceinline__ float bf2f(bf16_t u) { return __uint_as_float(((unsigned)u) << 16); }
__device__ __forceinline__ bf16_t f2bf(float f) { return (bf16_t)(cvt_pk_bf16(f, 0.f) & 0xffffu); }
__device__ __forceinline__ float sigmoidf_(float v) { return __builtin_amdgcn_rcpf(1.0f + __expf(-v)); }
__device__ __forceinline__ float wave_sum(float v) {
#pragma unroll
    for (int o = 1; o < 64; o <<= 1) v += __shfl_xor(v, o);
    return v;
}
__device__ __forceinline__ void unpack8(const u32x4 w, float (&f)[8]) {
    f[0] = bflo(w.x); f[1] = bfhi(w.x); f[2] = bflo(w.y); f[3] = bfhi(w.y); f[4] = bflo(w.z); f[5] = bfhi(w.z); f[6] = bflo(w.w); f[7] = bfhi(w.w);
}
__device__ __forceinline__ bf16x8 pack8(const float (&f)[8]) {
    u32x4 w; w.x = cvt_pk_bf16(f[0], f[1]); w.y = cvt_pk_bf16(f[2], f[3]); w.z = cvt_pk_bf16(f[4], f[5]); w.w = cvt_pk_bf16(f[6], f[7]);
    return __builtin_bit_cast(bf16x8, w);
}
#define MFMA16(a, b, c) __builtin_amdgcn_mfma_f32_16x16x32_bf16((a), (b), (c), 0, 0, 0)

struct Params {
    const float *x, *meta, *lb_logits, *norm1_g, *w_in, *hg_norm_g, *pool_w, *pool_scale, *conv_w, *w_branch, *w_o, *norm2_g, *w_up, *w_down, *final_g;
    float* out; unsigned char* ws;
};
namespace pg8 {
constexpr int BM = 256, BK = 64, HALF = 128, HTB = HALF * BK * 2, STAGE_BYTES = 8 * HTB, NXCD = 8, WGM = 8;
__device__ __forceinline__ int lds_byte(int r, int c) { const int st = (r >> 4) * 2 + (c >> 5), rr = r & 15, cc = c & 31, ob = rr * 64 + cc * 2; return st * 1024 + (ob ^ (((ob >> 9) & 1) << 5)); }
__device__ __forceinline__ void stage_rc(int b, int& R, int& C) { const int st = b / 1024, sb = b % 1024, swz = sb ^ (((sb >> 9) & 1) << 5); R = (st >> 1) * 16 + swz / 64; C = (st & 1) * 32 + (swz % 64) / 2; }
__device__ __forceinline__ int perm32(int rho) { const int n = rho >> 4, i = rho & 15; return 8 * (i >> 2) + 4 * n + (i & 3); }

struct Unit { int pm, pn, z; const char* a; const char* b; };
__device__ __forceinline__ int rowbase(int pm) { return (pm >> 5) * LSEQ + FRONT + (pm & 31) * 256; }

struct TileOrder {
    int nM, nN, nwg;
    __device__ __forceinline__ void init(int M, int N) { nM = M / BM; nN = N / BM; nwg = nM * nN; }
    __device__ __forceinline__ bool tile(long L, int& pm, int& pn) const {
        if (L >= nwg) return false;
        int wgid = (int)L; { const int q = nwg / NXCD, r = nwg % NXCD, xcd = wgid % NXCD, off = wgid / NXCD; wgid = (xcd < r ? xcd * (q + 1) : r * (q + 1) + (xcd - r) * q) + off; }
        const int nig = WGM * nN, gid = wgid / nig, fm = gid * WGM, gsz = (nM - fm) < WGM ? (nM - fm) : WGM;
        pm = fm + ((wgid % nig) % gsz); pn = (wgid % nig) / gsz; return true;
    }
};
struct SchedPlain {
    TileOrder T; int G, c; const char* A; const char* B; size_t astep, bstep;
    __device__ __forceinline__ bool next(int i, Unit& u) const {
        if (!T.tile((long)i * G + c, u.pm, u.pn)) return false;
        u.z = 0; u.a = A + (size_t)rowbase(u.pm) * astep; u.b = B + (size_t)u.pn * bstep; return true;
    }
};
struct SchedBranch {
    TileOrder T; int G, c; const char *A0, *A1, *A2, *A3; const char* B; size_t astep, bstep, bz;
    __device__ __forceinline__ bool next(int i, Unit& u) const {
        if (!T.tile((long)(i >> 2) * G + c, u.pm, u.pn)) return false;
        u.z = i & 3; const char* ab = u.z == 0 ? A0 : (u.z == 1 ? A1 : (u.z == 2 ? A2 : A3));
        u.a = ab + (size_t)rowbase(u.pm) * astep; u.b = B + (size_t)u.z * bz + (size_t)u.pn * bstep; return true;
    }
};

template <class Epi, class Sched>
__device__ __forceinline__ void gemm_phase(LAS unsigned char* lds, const int tid, const int lda, const int ldb, const int K, const Sched& S, const Epi& E) {
    const int wid = __builtin_amdgcn_readfirstlane(tid >> 6), lane = tid & 63, wr = wid >> 2, wc = wid & 3, fr = lane & 15, fq = lane >> 4;
    const int nt = K / BK;
    unsigned voffA[2], voffB[2];
#pragma unroll
    for (int i = 0; i < 2; ++i) { int R, C; stage_rc(tid * 16 + i * 8192, R, C); const int Rb = Epi::PERM ? ((R & ~31) + perm32(R & 31)) : R;
        voffA[i] = (unsigned)(R * lda + C) * 2u; voffB[i] = (unsigned)(Rb * ldb + C) * 2u; }
    const size_t kstep = (size_t)(BK * 2);
    const size_t hstepA = (size_t)HALF * lda * 2, hstepB = (size_t)HALF * ldb * 2;
    const unsigned ldsw = (unsigned)wid * 1024u;
    const int aoff = lds_byte(wr * 64 + fr, fq * 8), boff = lds_byte(wc * 32 + fr, fq * 8);
#define PG8_SA(b, h) (((b) * 2 + (h)) * HTB)
#define PG8_SB(b, h) ((4 + (b) * 2 + (h)) * HTB)
#define PG8_STAGE(bufoff, gbase, voff) do { _Pragma("unroll") for (int _i = 0; _i < 2; ++_i) \
        __builtin_amdgcn_global_load_lds((const unsigned*)((const char*)(gbase) + (voff)[_i]), (LAS unsigned*)(lds + (bufoff) + ldsw + _i * 8192), 16, 0, 0); } while (0)
#define PG8_LDA(dst, b, h) do { _Pragma("unroll") for (int m = 0; m < 4; ++m) _Pragma("unroll") for (int k = 0; k < 2; ++k) dst[m][k] = *(const LAS bf16x8*)(lds + PG8_SA(b, h) + aoff + m * 2048 + k * 1024); } while (0)
#define PG8_LDB(dst, b, h) do { _Pragma("unroll") for (int n = 0; n < 2; ++n) _Pragma("unroll") for (int k = 0; k < 2; ++k) dst[n][k] = *(const LAS bf16x8*)(lds + PG8_SB(b, h) + boff + n * 2048 + k * 1024); } while (0)
#define PG8_MMA(ai, bj, At, Bt) do { __builtin_amdgcn_s_setprio(1); _Pragma("unroll") for (int m = 0; m < 4; ++m) _Pragma("unroll") for (int n = 0; n < 2; ++n) _Pragma("unroll") for (int k = 0; k < 2; ++k) \
        acc[ai][bj][m][n] = __builtin_amdgcn_mfma_f32_16x16x32_bf16(Bt[n][k], At[m][k], acc[ai][bj][m][n], 0, 0, 0); __builtin_amdgcn_s_setprio(0); } while (0)
#define PG8_WAIT_V(n) asm volatile("s_waitcnt vmcnt(" #n ")" ::: "memory")
#define PG8_WAIT_L(n) asm volatile("s_waitcnt lgkmcnt(" #n ")" ::: "memory")
#define PG8_BAR __builtin_amdgcn_s_barrier()
#define PG8_SCHED __builtin_amdgcn_sched_barrier(0)
    Unit cur, nxt; int ui = 0;
    if (!S.next(0, cur)) return;
    f32x4 acc[2][2][4][2];
#pragma unroll
    for (int a = 0; a < 2; ++a)
#pragma unroll
        for (int b = 0; b < 2; ++b)
#pragma unroll
            for (int m = 0; m < 4; ++m)
#pragma unroll
                for (int n = 0; n < 2; ++n) acc[a][b][m][n] = (f32x4){0.f, 0.f, 0.f, 0.f};
    bf16x8 At[4][2], B0[2][2], B1[2][2];
    const char* cA = cur.a; const char* cB = cur.b;
    PG8_STAGE(PG8_SB(0, 0), cB, voffB); PG8_STAGE(PG8_SB(0, 1), cB + hstepB, voffB); PG8_STAGE(PG8_SA(0, 0), cA, voffA); PG8_STAGE(PG8_SA(0, 1), cA + hstepA, voffA);
    if (wr == 1) PG8_BAR;
    PG8_WAIT_V(2); PG8_BAR;
    PG8_STAGE(PG8_SB(1, 0), cB + kstep, voffB); PG8_STAGE(PG8_SA(1, 0), cA + kstep, voffA); PG8_STAGE(PG8_SB(1, 1), cB + hstepB + kstep, voffB);
    PG8_WAIT_V(6); PG8_BAR;
    for (;;) {
        const bool has_next = S.next(ui + 1, nxt);
        const char* nA = has_next ? nxt.a : cA; const char* nB = has_next ? nxt.b : cB;
        for (int t = 0; t < nt; t += 2) {
            const bool last = (t == nt - 2);
            const char* a1 = cA + (size_t)(t + 1) * kstep;
            const char* a2 = last ? nA : cA + (size_t)(t + 2) * kstep; const char* b2 = last ? nB : cB + (size_t)(t + 2) * kstep;
            const char* a3 = a2 + kstep; const char* b3 = b2 + kstep;
            PG8_LDB(B0, 0, 0); PG8_LDB(B1, 0, 1); PG8_SCHED; PG8_LDA(At, 0, 0); PG8_STAGE(PG8_SA(1, 1), a1 + hstepA, voffA);
            PG8_WAIT_V(8); PG8_WAIT_L(0); PG8_BAR; PG8_MMA(0, 0, At, B0); PG8_MMA(0, 1, At, B1); PG8_BAR; PG8_SCHED;
            PG8_LDA(At, 0, 1); PG8_STAGE(PG8_SB(0, 0), b2, voffB); PG8_STAGE(PG8_SB(0, 1), b2 + hstepB, voffB); PG8_STAGE(PG8_SA(0, 0), a2, voffA);
            PG8_WAIT_V(8); PG8_WAIT_L(0); PG8_BAR; PG8_MMA(1, 0, At, B0); PG8_MMA(1, 1, At, B1); PG8_BAR; PG8_SCHED;
            PG8_LDB(B0, 1, 0); PG8_LDB(B1, 1, 1); PG8_SCHED; PG8_LDA(At, 1, 0); PG8_STAGE(PG8_SA(0, 1), a2 + hstepA, voffA);
            PG8_WAIT_V(8); PG8_WAIT_L(0); PG8_BAR; PG8_MMA(0, 0, At, B0); PG8_MMA(0, 1, At, B1); PG8_BAR; PG8_SCHED;
            PG8_LDA(At, 1, 1); PG8_STAGE(PG8_SB(1, 0), b3, voffB); PG8_STAGE(PG8_SB(1, 1), b3 + hstepB, voffB); PG8_STAGE(PG8_SA(1, 0), a3, voffA);
            PG8_WAIT_V(8); PG8_WAIT_L(0); PG8_BAR; PG8_MMA(1, 0, At, B0); PG8_MMA(1, 1, At, B1); PG8_BAR; PG8_SCHED;
        }
        if (wr == 0) PG8_BAR;
        E(acc, cur, wr, wc, fr, fq);
        if (!has_next) break;
#pragma unroll
        for (int a = 0; a < 2; ++a)
#pragma unroll
            for (int b = 0; b < 2; ++b)
#pragma unroll
                for (int m = 0; m < 4; ++m)
#pragma unroll
                    for (int n = 0; n < 2; ++n) acc[a][b][m][n] = (f32x4){0.f, 0.f, 0.f, 0.f};
        cur = nxt; cA = nA; cB = nB; ++ui;
        if (wr == 1) PG8_BAR;
    }
    PG8_WAIT_V(0);
    PG8_BAR;
#undef PG8_SA
#undef PG8_SB
#undef PG8_STAGE
#undef PG8_LDA
#undef PG8_LDB
#undef PG8_MMA
#undef PG8_WAIT_V
#undef PG8_WAIT_L
#undef PG8_BAR
#undef PG8_SCHED
}
}
using pg8::Unit;

__device__ __forceinline__ float row_rstd(const float* st, int row) {
    const f32x4* p = (const f32x4*)(st + (size_t)row * 16);
    const f32x4 a = p[0], b = p[1], c = p[2], d = p[3];
    const float s = ((a.x + a.y) + (a.z + a.w)) + ((b.x + b.y) + (b.z + b.w)) + ((c.x + c.y) + (c.z + c.w)) + ((d.x + d.y) + (d.z + d.w));
    return rsqrtf(s * (1.0f / DM) + EPS);
}

struct EpiIn {
    static constexpr bool PERM = true;
    unsigned char* ws; const float* lb;
    __device__ __forceinline__ void operator()(const f32x4 (&acc)[2][2][4][2], const Unit& u, int wr, int wc, int fr, int fq) const {
        const float* st = (const float*)(ws + WS_ST1);
        const int cgp = u.pn >> 1;
        const int ccb = (u.pn & 1) * 256 + wc * 32 + 8 * fq;
        int dstg = -1;
        if (cgp == 0) dstg = 0; else if (cgp == 1) dstg = 3; else if (cgp == 3) dstg = 4; else if (cgp == 4) dstg = 5; else if (cgp == 5) dstg = 1;
        else if (cgp == 6) dstg = 6; else if (cgp == 8) dstg = 7; else if (cgp == 9) dstg = 2; else if (cgp == 10) dstg = 8;
#pragma unroll
        for (int ai = 0; ai < 2; ++ai)
#pragma unroll
            for (int m = 0; m < 4; ++m) {
                const int row = pg8::rowbase(u.pm) + ai * 128 + wr * 64 + m * 16 + fr;
                const float rs = row_rstd(st, row);
                const int bb = row >= LSEQ ? 1 : 0, t = row - bb * LSEQ;
#pragma unroll
                for (int bj = 0; bj < 2; ++bj) {
                    const int cc = ccb + bj * 128;
                    float v[8];
#pragma unroll
                    for (int e = 0; e < 4; ++e) { v[e] = acc[ai][bj][m][0][e] * rs; v[4 + e] = acc[ai][bj][m][1][e] * rs; }
                    if (cgp >= 11) {
#pragma unroll
                        for (int e = 0; e < 8; ++e) v[e] = sigmoidf_(v[e]);
                        bf16_t* dst = (bf16_t*)(ws + WS_GATE) + (size_t)row * DFF + (cgp - 11) * 512 + cc;
                        *(u32x4*)dst = __builtin_bit_cast(u32x4, pack8(v));
                    } else if (cgp == 2 || cgp == 7) {
                        bf16_t* dst = (bf16_t*)(ws + (cgp == 2 ? WS_IT : WS_VT)) + ((size_t)(bb * 512 + cc)) * LSEQ + t;
#pragma unroll
                        for (int e = 0; e < 8; ++e) dst[(size_t)e * LSEQ] = f2bf(v[e]);
                    } else {
                        if (cgp == 1) {
                            const bool valid = t >= NVALID0;
                            const f32x4 l0 = *(const f32x4*)(lb + cc), l1 = *(const f32x4*)(lb + cc + 4);
                            float lf[8];
#pragma unroll
                            for (int e = 0; e < 8; ++e) { const float lbv = e < 4 ? l0[e] : l1[e - 4]; const float sg = sigmoidf_(v[e]);
                                lf[e] = valid ? __logf(lbv + (1.0f - lbv) * sg) : 0.f; v[e] = valid ? (1.0f - lbv) * (1.0f - sg) : 0.f; }
                            float* ld = (float*)(ws + WS_LOGF) + (size_t)row * BW + cc;
                            *(f32x4*)ld = (f32x4){lf[0], lf[1], lf[2], lf[3]}; *(f32x4*)(ld + 4) = (f32x4){lf[4], lf[5], lf[6], lf[7]};
                        } else if (cgp == 3) {
#pragma unroll
                            for (int e = 0; e < 8; ++e) v[e] = sigmoidf_(v[e]);
                        } else if (cgp == 5) {
#pragma unroll
                            for (int e = 0; e < 8; ++e) v[e] *= 0.125f;
                        }
                        bf16_t* dst = (bf16_t*)(ws + WS_MIX + (size_t)dstg * SZ_G) + (size_t)row * BW + cc;
                        *(u32x4*)dst = __builtin_bit_cast(u32x4, pack8(v));
                    }
                }
            }
    }
};

struct EpiBranch {
    static constexpr bool PERM = false;
    unsigned char* ws;
    __device__ __forceinline__ void operator()(const f32x4 (&acc)[2][2][4][2], const Unit& u, int wr, int wc, int fr, int fq) const {
        const bf16_t* G = (const bf16_t*)(ws + WS_GATE); float* MF = (float*)(ws + WS_MIXEDF); bf16_t* MB = (bf16_t*)(ws + WS_MIXEDB);
        const int z = u.z;
#pragma unroll
        for (int ai = 0; ai < 2; ++ai)
#pragma unroll
            for (int m = 0; m < 4; ++m) {
                const int row = pg8::rowbase(u.pm) + ai * 128 + wr * 64 + m * 16 + fr;
#pragma unroll
                for (int bj = 0; bj < 2; ++bj)
#pragma unroll
                    for (int n = 0; n < 2; ++n) {
                        const int col = u.pn * 256 + bj * 128 + wc * 32 + n * 16 + 4 * fq;
                        const u32x2 gw = *(const u32x2*)(G + (size_t)row * DFF + z * DM + col);
                        f32x4 val = acc[ai][bj][m][n] * (f32x4){bflo(gw.x), bfhi(gw.x), bflo(gw.y), bfhi(gw.y)};
                        float* mp = MF + (size_t)row * DM + col;
                        if (z > 0) val += *(const f32x4*)mp;
                        if (z < 3) *(f32x4*)mp = val;
                        else { u32x2 w; w.x = cvt_pk_bf16(val[0], val[1]); w.y = cvt_pk_bf16(val[2], val[3]); *(u32x2*)(MB + (size_t)row * DM + col) = w; }
                    }
            }
    }
};

struct EpiResid {
    static constexpr bool PERM = false;
    unsigned char* ws; float* stat;
    __device__ __forceinline__ void operator()(const f32x4 (&acc)[2][2][4][2], const Unit& u, int wr, int wc, int fr, int fq) const {
        float* X = (float*)(ws + WS_X); bf16_t* XN = (bf16_t*)(ws + WS_XN);
#pragma unroll
        for (int ai = 0; ai < 2; ++ai)
#pragma unroll
            for (int m = 0; m < 4; ++m) {
                const int row = pg8::rowbase(u.pm) + ai * 128 + wr * 64 + m * 16 + fr;
                float ss = 0.f;
#pragma unroll
                for (int bj = 0; bj < 2; ++bj)
#pragma unroll
                    for (int n = 0; n < 2; ++n) {
                        const int col = u.pn * 256 + bj * 128 + wc * 32 + n * 16 + 4 * fq;
                        float* xp = X + (size_t)row * DM + col;
                        const f32x4 xv = *(const f32x4*)xp + acc[ai][bj][m][n];
                        *(f32x4*)xp = xv;
                        u32x2 w; w.x = cvt_pk_bf16(xv[0], xv[1]); w.y = cvt_pk_bf16(xv[2], xv[3]); *(u32x2*)(XN + (size_t)row * DM + col) = w;
                        ss += (xv[0] * xv[0] + xv[1] * xv[1]) + (xv[2] * xv[2] + xv[3] * xv[3]);
                    }
                ss += __shfl_xor(ss, 16); ss += __shfl_xor(ss, 32);
                if (fq == 0) stat[(size_t)row * 16 + u.pn * 4 + wc] = ss;
            }
    }
};

struct EpiUp {
    static constexpr bool PERM = true;
    unsigned char* ws;
    __device__ __forceinline__ void operator()(const f32x4 (&acc)[2][2][4][2], const Unit& u, int wr, int wc, int fr, int fq) const {
        const float* st = (const float*)(ws + WS_ST2); bf16_t* H = (bf16_t*)(ws + WS_H);
#pragma unroll
        for (int ai = 0; ai < 2; ++ai)
#pragma unroll
            for (int m = 0; m < 4; ++m) {
                const int row = pg8::rowbase(u.pm) + ai * 128 + wr * 64 + m * 16 + fr;
                const float rs = row_rstd(st, row);
#pragma unroll
                for (int bj = 0; bj < 2; ++bj) {
                    float v[8];
#pragma unroll
                    for (int e = 0; e < 4; ++e) { float a = fmaxf(acc[ai][bj][m][0][e] * rs, 0.f), b = fmaxf(acc[ai][bj][m][1][e] * rs, 0.f); v[e] = a * a; v[4 + e] = b * b; }
                    *(u32x4*)(H + (size_t)row * DFF + u.pn * 256 + bj * 128 + wc * 32 + 8 * fq) = __builtin_bit_cast(u32x4, pack8(v));
                }
            }
    }
};
__device__ __forceinline__ void transpose_item(const float* W, int K, int N, const float* ks, bf16_t* WT, LAS float* scr, int item, int lane) {
    const int nblk = N / 32, kb = item / nblk, nb = item % nblk, k0 = 64 * kb, n0 = 32 * nb;
#pragma unroll 8
    for (int i = 0; i < 32; ++i) { const int kk = 2 * i + (lane >> 5); float w = W[(size_t)(k0 + kk) * N + n0 + (lane & 31)]; if (ks) w *= ks[k0 + kk]; scr[kk * 33 + (lane & 31)] = w; }
    asm volatile("s_waitcnt lgkmcnt(0)" ::: "memory");
    const int c = lane & 7;
#pragma unroll
    for (int j = 0; j < 4; ++j) { const int n = (lane >> 3) + 8 * j; const LAS float* s = scr + (8 * c) * 33 + n;
        u32x4 o; o.x = cvt_pk_bf16(s[0 * 33], s[1 * 33]); o.y = cvt_pk_bf16(s[2 * 33], s[3 * 33]); o.z = cvt_pk_bf16(s[4 * 33], s[5 * 33]); o.w = cvt_pk_bf16(s[6 * 33], s[7 * 33]);
        *(u32x4*)(WT + (size_t)(n0 + n) * K + k0 + 8 * c) = o; }
    asm volatile("s_waitcnt lgkmcnt(0)" ::: "memory");
}
__device__ __forceinline__ void convert_layer(const Params& p, int l, LAS unsigned char* lds, int gw, int NGW, int wave, int lane) {
    LAS float* scr = (LAS float*)(lds + wave * 16384);
    unsigned char* ws = p.ws;
    constexpr int I_IN = (DM / 64) * (INC / 32), I_BR = (BW / 64) * (DM / 32), I_O = (DM / 64) * (DM / 32), I_UP = (DM / 64) * (DFF / 32), I_DN = (DFF / 64) * (DM / 32);
    constexpr int NIT = I_IN + 4 * I_BR + I_O + I_UP + I_DN;
    for (int it = gw; it < NIT; it += NGW) {
        int r = it;
        if (r < I_IN) { transpose_item(p.w_in + (size_t)l * DM * INC, DM, INC, p.norm1_g + l * DM, (bf16_t*)(ws + WS_WIN), scr, r, lane); continue; } r -= I_IN;
        if (r < 4 * I_BR) { const int n = r / I_BR; transpose_item(p.w_branch + ((size_t)l * 4 + n) * BW * DM, BW, DM, nullptr, (bf16_t*)(ws + WS_WBR) + (size_t)n * DM * BW, scr, r % I_BR, lane); continue; } r -= 4 * I_BR;
        if (r < I_O) { transpose_item(p.w_o + (size_t)l * DM * DM, DM, DM, nullptr, (bf16_t*)(ws + WS_WO), scr, r, lane); continue; } r -= I_O;
        if (r < I_UP) { transpose_item(p.w_up + (size_t)l * DM * DFF, DM, DFF, p.norm2_g + l * DM, (bf16_t*)(ws + WS_WUP), scr, r, lane); continue; } r -= I_UP;
        transpose_item(p.w_down + (size_t)l * DFF * DM, DFF, DM, nullptr, (bf16_t*)(ws + WS_WDN), scr, r, lane);
    }
}
__device__ __forceinline__ void prologue_misc(const Params& p, int gw, int NGW, int lane) {
    unsigned char* ws = p.ws;
    const int gt = gw * 64 + lane, NGT = NGW * 64;
    if (gt < BW) {
        float a[4], mx = -1e30f;
#pragma unroll
        for (int l = 0; l < 4; ++l) { a[l] = p.lb_logits[l * BW + gt]; mx = fmaxf(mx, a[l]); }
        float s = 0.f;
#pragma unroll
        for (int l = 0; l < 4; ++l) { a[l] = expf(a[l] - mx); s += a[l]; }
        float cum = 0.f; float* LB = (float*)(ws + WS_LB);
#pragma unroll
        for (int l = 0; l < 4; ++l) { LB[l * BW + gt] = cum; if (l < 3) cum += a[l + 1] / s; }
    }
    for (int i = gt; i < 4 * 4 * 128 * 128; i += NGT) {
        const int c = i & 127, d = (i >> 7) & 127, lg = i >> 14;
        ((bf16_t*)(ws + WS_PWT))[i] = f2bf(p.pool_w[((size_t)lg * 128 + c) * 128 + d] * p.pool_scale[lg * 128 + d]);
    }
    float* X = (float*)(ws + WS_X); bf16_t* XN = (bf16_t*)(ws + WS_XN); float* ST = (float*)(ws + WS_ST1);
    for (int row = gw; row < ROWS; row += NGW) {
        const int b = row >= LSEQ ? 1 : 0, t = row - b * LSEQ;
        const float* src = t < NVALID0 ? nullptr : (t < FRONT ? p.meta + (size_t)(t - NVALID0) * DM : p.x + ((size_t)b * SEQ + (t - FRONT)) * DM);
        float ss = 0.f;
#pragma unroll
        for (int j = 0; j < 4; ++j) {
            f32x4 v = src ? *((const f32x4*)src + 64 * j + lane) : (f32x4){0.f, 0.f, 0.f, 0.f};
            *((f32x4*)(X + (size_t)row * DM) + 64 * j + lane) = v;
            u32x2 w; w.x = cvt_pk_bf16(v[0], v[1]); w.y = cvt_pk_bf16(v[2], v[3]); *((u32x2*)(XN + (size_t)row * DM) + 64 * j + lane) = w;
            ss += (v[0] * v[0] + v[1] * v[1]) + (v[2] * v[2] + v[3] * v[3]);
        }
        ss = wave_sum(ss);
        if (lane < 16) ST[(size_t)row * 16 + lane] = lane == 0 ? ss : 0.f;
    }
}
__device__ __forceinline__ void final_norm(const Params& p, int gw, int NGW, int lane) {
    const float* X = (const float*)(p.ws + WS_X);
    for (int r = gw; r < BATCH * SEQ; r += NGW) {
        const int b = r / SEQ, s = r - b * SEQ; const size_t row = (size_t)b * LSEQ + FRONT + s;
        f32x4 v[4]; float ss = 0.f;
#pragma unroll
        for (int j = 0; j < 4; ++j) { v[j] = *((const f32x4*)(X + row * DM) + 64 * j + lane); ss += (v[j][0] * v[j][0] + v[j][1] * v[j][1]) + (v[j][2] * v[j][2] + v[j][3] * v[j][3]); }
        const float rs = rsqrtf(wave_sum(ss) * (1.0f / DM) + EPS);
#pragma unroll
        for (int j = 0; j < 4; ++j) { const f32x4 g = *((const f32x4*)p.final_g + 64 * j + lane); f32x4 ov = v[j] * rs * g;
#ifdef NANFIX
            for (int e = 0; e < 4; ++e) if (!(fabsf(ov[e]) < 1e30f)) ov[e] = 0.f;
#endif
            *((f32x4*)(p.out + (size_t)r * DM) + 64 * j + lane) = ov; }
    }
}

constexpr int PP = 136;
constexpr int BP = 132;

__device__ __forceinline__ void hgrn2_local(unsigned char* ws, LAS unsigned char* lds, int item, int tid, int wave, int lane) {
    const int h = item & 3, bc = item >> 2, b = bc / NCH, c = bc - b * NCH;
    const size_t row0 = (size_t)b * LSEQ + (size_t)c * 128;
    LAS float* Bs = (LAS float*)lds;
    LAS float* tot = (LAS float*)(lds + 128 * BP * 4);
    LAS bf16_t* KT = (LAS bf16_t*)(lds + 128 * BP * 4 + 2048);
    float* LF = (float*)(ws + WS_LOGF) + row0 * BW + h * 128;
    for (int i = tid; i < 128 * 32; i += NT) { const int s = i >> 5, c4 = (i & 31) * 4; *(LAS f32x4*)(Bs + s * BP + c4) = *(const f32x4*)(LF + (size_t)s * BW + c4); }
    __syncthreads();
    { const int k = tid & 127, seg = tid >> 7; float run = 0.f;
      for (int s = seg * 32; s < seg * 32 + 32; ++s) { run += Bs[s * BP + k]; Bs[s * BP + k] = run; }
      tot[seg * 128 + k] = run;
      __syncthreads();
      float off = 0.f;
      for (int q = 0; q < seg; ++q) off += tot[q * 128 + k];
      if (seg > 0) for (int s = seg * 32; s < seg * 32 + 32; ++s) Bs[s * BP + k] += off;
    }
    __syncthreads();
    for (int i = tid; i < 128 * 32; i += NT) { const int s = i >> 5, c4 = (i & 31) * 4; *(f32x4*)(LF + (size_t)s * BW + c4) = *(const LAS f32x4*)(Bs + s * BP + c4); }
    if (tid < 128) ((float*)(ws + WS_DEC))[(size_t)(bc * 4 + h) * 128 + tid] = __expf(Bs[127 * BP + tid]);
    const bf16_t* KK = (const bf16_t*)(ws + WS_MIX + 3 * SZ_G) + row0 * BW + h * 128;
    for (int i = tid; i < 128 * 16; i += NT) {
        const int s = i >> 4, k0 = (i & 15) * 8; float kv[8]; unpack8(*(const u32x4*)(KK + (size_t)s * BW + k0), kv);
#pragma unroll
        for (int e = 0; e < 8; ++e) KT[(k0 + e) * PP + s] = f2bf(kv[e] * __expf(Bs[127 * BP + k0 + e] - Bs[s * BP + k0 + e]));
    }
    __syncthreads();
    const int g = lane >> 4, l16 = lane & 15;
    f32x4 acc[8];
#pragma unroll
    for (int nb = 0; nb < 8; ++nb) acc[nb] = (f32x4){0.f, 0.f, 0.f, 0.f};
    const bf16_t* IT = (const bf16_t*)(ws + WS_IT) + ((size_t)(b * 512 + h * 128)) * LSEQ + c * 128;
#pragma unroll
    for (int ks = 0; ks < 4; ++ks) {
        const bf16x8 a = *(const LAS bf16x8*)(KT + (16 * wave + l16) * PP + 32 * ks + 8 * g);
#pragma unroll
        for (int nb = 0; nb < 8; ++nb) { const bf16x8 bf = *(const bf16x8*)(IT + (size_t)(16 * nb + l16) * LSEQ + 32 * ks + 8 * g); acc[nb] = MFMA16(a, bf, acc[nb]); }
    }
    float* DS = (float*)(ws + WS_DS) + (size_t)(bc * 4 + h) * 16384;
#pragma unroll
    for (int nb = 0; nb < 8; ++nb) *(f32x4*)(DS + (size_t)(16 * nb + l16) * 128 + 16 * wave + 4 * g) = acc[nb];
    __syncthreads();
}

__device__ __forceinline__ void hgrn2_scan(unsigned char* ws, int gt, int NGT) {
    const float* DS = (const float*)(ws + WS_DS); const float* DEC = (const float*)(ws + WS_DEC); bf16_t* SP = (bf16_t*)(ws + WS_SPREV);
    for (int e = gt; e < 8 * 16384; e += NGT) {
        const int bh = e >> 14, vk = e & 16383, b = bh >> 2, h = bh & 3, k = vk & 127;
        float S = 0.f;
#pragma unroll 5
        for (int c = 0; c < NCH; ++c) {
            const size_t ci = (size_t)((b * NCH + c) * 4 + h);
            SP[ci * 16384 + vk] = f2bf(S);
            S = DEC[ci * 128 + k] * S + DS[ci * 16384 + vk];
        }
    }
}

__device__ __forceinline__ void hgrn2_out(unsigned char* ws, const float* ng, LAS unsigned char* lds, int item, int tid, int wave, int lane) {
    const int h = item & 3, bc = item >> 2, b = bc / NCH, c = bc - b * NCH;
    const size_t row0 = (size_t)b * LSEQ + (size_t)c * 128;
    LAS bf16_t* Pm = (LAS bf16_t*)lds;
    const float* Bc = (const float*)(ws + WS_LOGF) + row0 * BW + h * 128;
    bf16_t* Q = (bf16_t*)(ws + WS_MIX) + row0 * BW + h * 128;
    const bf16_t* KK = (const bf16_t*)(ws + WS_MIX + 3 * SZ_G) + row0 * BW + h * 128;
    const bf16_t* SG = (const bf16_t*)(ws + WS_MIX + 4 * SZ_G) + row0 * BW + h * 128;
    const int g = lane >> 4, l16 = lane & 15;
    {
        const int j = wave;
        float rj[4][8];
#pragma unroll
        for (int ks = 0; ks < 4; ++ks) {
            f32x4 r0 = (f32x4){0.f, 0.f, 0.f, 0.f}, r1 = r0;
            if (j > 0) { const float* rp = Bc + (size_t)(16 * j - 1) * BW + 32 * ks + 8 * g; r0 = *(const f32x4*)rp; r1 = *(const f32x4*)(rp + 4); }
#pragma unroll
            for (int e = 0; e < 4; ++e) { rj[ks][e] = r0[e]; rj[ks][4 + e] = r1[e]; }
        }
        bf16x8 kf[4];
        { const int s = 16 * j + l16;
#pragma unroll
          for (int ks = 0; ks < 4; ++ks) {
              const int k0 = 32 * ks + 8 * g; float kv[8]; unpack8(*(const u32x4*)(KK + (size_t)s * BW + k0), kv);
              const f32x4 b0 = *(const f32x4*)(Bc + (size_t)s * BW + k0), b1 = *(const f32x4*)(Bc + (size_t)s * BW + k0 + 4);
#pragma unroll
              for (int e = 0; e < 8; ++e) kv[e] *= __expf(fminf(rj[ks][e] - (e < 4 ? b0[e] : b1[e - 4]), 80.f));
              kf[ks] = pack8(kv);
          } }
        for (int i = j; i < 8; ++i) {
            const int t = 16 * i + l16;
            f32x4 sc = (f32x4){0.f, 0.f, 0.f, 0.f};
#pragma unroll
            for (int ks = 0; ks < 4; ++ks) {
                const int k0 = 32 * ks + 8 * g; float qv[8]; unpack8(*(const u32x4*)(Q + (size_t)t * BW + k0), qv);
                const f32x4 b0 = *(const f32x4*)(Bc + (size_t)t * BW + k0), b1 = *(const f32x4*)(Bc + (size_t)t * BW + k0 + 4);
#pragma unroll
                for (int e = 0; e < 8; ++e) qv[e] *= __expf((e < 4 ? b0[e] : b1[e - 4]) - rj[ks][e]);
                sc = MFMA16(pack8(qv), kf[ks], sc);
            }
#pragma unroll
            for (int r = 0; r < 4; ++r) { float v = sc[r]; if (i == j && l16 > 4 * g + r) v = 0.f; Pm[(16 * i + 4 * g + r) * PP + 16 * j + l16] = f2bf(v); }
        }
        for (int i = 0; i < j; ++i)
#pragma unroll
            for (int r = 0; r < 4; ++r) Pm[(16 * i + 4 * g + r) * PP + 16 * j + l16] = 0;
    }
    __syncthreads();
    f32x4 o[8];
#pragma unroll
    for (int nb = 0; nb < 8; ++nb) o[nb] = (f32x4){0.f, 0.f, 0.f, 0.f};
    const bf16_t* IT = (const bf16_t*)(ws + WS_IT) + ((size_t)(b * 512 + h * 128)) * LSEQ + c * 128;
    const int nks = (16 * wave + 15) / 32 + 1;
    for (int ks = 0; ks < nks; ++ks) {
        const bf16x8 a = *(const LAS bf16x8*)(Pm + (16 * wave + l16) * PP + 32 * ks + 8 * g);
#pragma unroll
        for (int nb = 0; nb < 8; ++nb) { const bf16x8 bf = *(const bf16x8*)(IT + (size_t)(16 * nb + l16) * LSEQ + 32 * ks + 8 * g); o[nb] = MFMA16(a, bf, o[nb]); }
    }
    const bf16_t* SP = (const bf16_t*)(ws + WS_SPREV) + (size_t)(bc * 4 + h) * 16384;
    { const int t = 16 * wave + l16;
#pragma unroll
      for (int ks = 0; ks < 4; ++ks) {
          const int k0 = 32 * ks + 8 * g; float qv[8]; unpack8(*(const u32x4*)(Q + (size_t)t * BW + k0), qv);
          const f32x4 b0 = *(const f32x4*)(Bc + (size_t)t * BW + k0), b1 = *(const f32x4*)(Bc + (size_t)t * BW + k0 + 4);
#pragma unroll
          for (int e = 0; e < 8; ++e) qv[e] *= __expf(e < 4 ? b0[e] : b1[e - 4]);
          const bf16x8 a = pack8(qv);
#pragma unroll
          for (int nb = 0; nb < 8; ++nb) { const bf16x8 bf = *(const bf16x8*)(SP + (size_t)(16 * nb + l16) * 128 + k0); o[nb] = MFMA16(a, bf, o[nb]); }
      } }
    float rs[4];
#pragma unroll
    for (int r = 0; r < 4; ++r) { float ss = 0.f;
#pragma unroll
        for (int nb = 0; nb < 8; ++nb) ss += o[nb][r] * o[nb][r];
        ss += __shfl_xor(ss, 1); ss += __shfl_xor(ss, 2); ss += __shfl_xor(ss, 4); ss += __shfl_xor(ss, 8);
        rs[r] = rsqrtf(ss * (1.0f / 128.f) + EPS); }
    __syncthreads();
#pragma unroll
    for (int nb = 0; nb < 8; ++nb) { const int v = 16 * nb + l16; const float gn = ng[h * 128 + v];
#pragma unroll
        for (int r = 0; r < 4; ++r) { const int t = 16 * wave + 4 * g + r; Q[(size_t)t * BW + v] = f2bf(o[nb][r] * rs[r] * gn * bf2f(SG[(size_t)t * BW + v])); } }
}

__device__ __forceinline__ void pool_item(unsigned char* ws, int l, int item, int wave, int lane) {
    const int grp = item & 3, ch = item >> 2, b = ch / NCH;
    const int g = lane >> 4, l16 = lane & 15;
    const int row = ch * 128 + 16 * wave + l16, t = row - b * LSEQ, wnd = 2 << grp;
    const bf16_t* PV = (const bf16_t*)(ws + WS_MIX + 5 * SZ_G);
    const float invn = 1.0f / (float)max(min(wnd, t - (NVALID0 - 1)), 1);
    bf16x8 af[4];
#pragma unroll
    for (int ks = 0; ks < 4; ++ks) {
        const int c0 = grp * 128 + 32 * ks + 8 * g; float sum[8], v0[8];
        unpack8(*(const u32x4*)(PV + (size_t)row * BW + c0), v0);
#pragma unroll
        for (int e = 0; e < 8; ++e) sum[e] = v0[e];
        for (int i = 1; i < wnd; ++i) if (t - i >= 0) { float vv[8]; unpack8(*(const u32x4*)(PV + (size_t)(row - i) * BW + c0), vv);
#pragma unroll
            for (int e = 0; e < 8; ++e) sum[e] += vv[e]; }
#pragma unroll
        for (int e = 0; e < 8; ++e) sum[e] = sum[e] * invn - v0[e];
        af[ks] = pack8(sum);
    }
    const bf16_t* PW = (const bf16_t*)(ws + WS_PWT) + (size_t)(l * 4 + grp) * 16384;
    bf16_t* PO = (bf16_t*)(ws + WS_POOLO);
#pragma unroll
    for (int nb = 0; nb < 8; ++nb) {
        f32x4 o = (f32x4){0.f, 0.f, 0.f, 0.f};
#pragma unroll
        for (int ks = 0; ks < 4; ++ks) o = MFMA16(af[ks], *(const bf16x8*)(PW + (size_t)(16 * nb + l16) * 128 + 32 * ks + 8 * g), o);
#pragma unroll
        for (int r = 0; r < 4; ++r) PO[(size_t)(ch * 128 + 16 * wave + 4 * g + r) * BW + grp * 128 + 16 * nb + l16] = f2bf(o[r]);
    }
}

__device__ __forceinline__ void conv_item(unsigned char* ws, const float* cw, int ch, int tid) {
    const int b = ch / NCH;
    const bf16_t* Hh = (const bf16_t*)(ws + WS_MIX + 7 * SZ_G); const bf16_t* Cc = (const bf16_t*)(ws + WS_MIX + 8 * SZ_G); bf16_t* Bb = (bf16_t*)(ws + WS_MIX + 2 * SZ_G);
    for (int i = tid; i < 128 * 64; i += NT) {
        const int row = ch * 128 + (i >> 6), c0 = (i & 63) * 8, t = row - b * LSEQ;
        float y[8];
#pragma unroll
        for (int e = 0; e < 8; ++e) y[e] = 0.f;
#pragma unroll
        for (int j = 0; j < 3; ++j) { const int d = 2 - j; if (t - d >= 0) {
            float hv[8], cv[8]; unpack8(*(const u32x4*)(Hh + (size_t)(row - d) * BW + c0), hv); unpack8(*(const u32x4*)(Cc + (size_t)(row - d) * BW + c0), cv);
            const f32x4 w0 = *(const f32x4*)(cw + j * BW + c0), w1 = *(const f32x4*)(cw + j * BW + c0 + 4);
#pragma unroll
            for (int e = 0; e < 8; ++e) y[e] += (e < 4 ? w0[e] : w1[e - 4]) * (cv[e] * hv[e]); } }
        float bv[8]; unpack8(*(const u32x4*)(Bb + (size_t)row * BW + c0), bv);
#pragma unroll
        for (int e = 0; e < 8; ++e) y[e] *= bv[e];
        *(u32x4*)(Bb + (size_t)row * BW + c0) = __builtin_bit_cast(u32x4, pack8(y));
    }
}

__device__ __forceinline__ void attn_item(unsigned char* ws, LAS unsigned char* lds, int item, int wave, int lane) {
    const int qb = item % NCH, bh = item / NCH, h = bh & 7, b = bh >> 3;
    const int t0 = qb * 128 + 16 * wave;
    if (t0 < NVALID0) return;
    const int g = lane >> 4, l16 = lane & 15;
    bf16_t* Q = (bf16_t*)(ws + WS_MIX + 1 * SZ_G) + (size_t)b * LSEQ * BW + h * 64;
    const bf16_t* Kk = (const bf16_t*)(ws + WS_MIX + 6 * SZ_G) + (size_t)b * LSEQ * BW + h * 64;
    const bf16_t* VT = (const bf16_t*)(ws + WS_VT) + ((size_t)(b * 512 + h * 64)) * LSEQ;
    LAS bf16_t* PW = (LAS bf16_t*)(lds + wave * 4096);
    const bf16x8 qa0 = *(const bf16x8*)(Q + (size_t)(t0 + l16) * BW + 8 * g), qa1 = *(const bf16x8*)(Q + (size_t)(t0 + l16) * BW + 32 + 8 * g);
    float R[4] = {0.f, 0.f, 0.f, 0.f};
    f32x4 o[4];
#pragma unroll
    for (int nb = 0; nb < 4; ++nb) o[nb] = (f32x4){0.f, 0.f, 0.f, 0.f};
    for (int kb = (t0 + 15) >> 6; kb >= 1; --kb) {
        f32x4 sc[4];
#pragma unroll
        for (int nb = 0; nb < 4; ++nb) {
            const bf16_t* kp = Kk + (size_t)(64 * kb + 16 * nb + l16) * BW + 8 * g;
            sc[nb] = MFMA16(qa0, *(const bf16x8*)kp, ((f32x4){0.f, 0.f, 0.f, 0.f}));
            sc[nb] = MFMA16(qa1, *(const bf16x8*)(kp + 32), sc[nb]);
        }
        float lk[4][4], ls[4][4], tot[4][4];
#pragma unroll
        for (int nb = 0; nb < 4; ++nb)
#pragma unroll
            for (int r = 0; r < 4; ++r) {
                const int s = 64 * kb + 16 * nb + l16, t = t0 + 4 * g + r; const bool valid = (s < t) && (s >= NVALID0);
                const float z = sc[nb][r]; const float sp = fmaxf(z, 0.f) + __logf(1.0f + __expf(-fabsf(z)));
                lk[nb][r] = valid ? -sp : 0.f; ls[nb][r] = valid ? (z - sp) : -1e30f;
                float inc = lk[nb][r];
#pragma unroll
                for (int d = 1; d < 16; d <<= 1) { const float tmp = __shfl_down(inc, d, 16); inc += (l16 + d < 16) ? tmp : 0.f; }
                tot[nb][r] = __shfl(inc, 0, 16);
                lk[nb][r] = inc - lk[nb][r];
            }
#pragma unroll
        for (int r = 0; r < 4; ++r) {
            float off = R[r];
#pragma unroll
            for (int nb = 3; nb >= 0; --nb) {
                const float a = __expf(ls[nb][r] + lk[nb][r] + off);
                PW[(4 * g + r) * 72 + 16 * nb + l16] = f2bf(a);
                off += tot[nb][r];
            }
            R[r] = off;
        }
        asm volatile("s_waitcnt lgkmcnt(0)" ::: "memory");
#pragma unroll
        for (int ks = 0; ks < 2; ++ks) {
            const bf16x8 a = *(const LAS bf16x8*)(PW + l16 * 72 + 32 * ks + 8 * g);
#pragma unroll
            for (int nb = 0; nb < 4; ++nb) o[nb] = MFMA16(a, *(const bf16x8*)(VT + (size_t)(16 * nb + l16) * LSEQ + 64 * kb + 32 * ks + 8 * g), o[nb]);
        }
        asm volatile("s_waitcnt lgkmcnt(0)" ::: "memory");
        float mx = fmaxf(fmaxf(R[0], R[1]), fmaxf(R[2], R[3]));
        mx = fmaxf(mx, __shfl_xor(mx, 16)); mx = fmaxf(mx, __shfl_xor(mx, 32));
        if (mx < -105.f) break;
    }
#pragma unroll
    for (int nb = 0; nb < 4; ++nb)
#pragma unroll
        for (int r = 0; r < 4; ++r) Q[(size_t)(t0 + 4 * g + r) * BW + 16 * nb + l16] = f2bf(o[nb][r]);
}
template <bool SS>
__device__ __forceinline__ void skinny_unit(LAS unsigned char* lds, const bf16_t* A0, int lda, const bf16_t* B0, int ldb, int K, int tid, int wave, int lane, float& val, float& rowss) {
    const int g = lane >> 4, l16 = lane & 15, ksl = K >> 3, k0 = wave * ksl;
    LAS float* part = (LAS float*)lds;
    LAS float* ssp = part + 8 * 16 * 17;
    f32x4 acc = (f32x4){0.f, 0.f, 0.f, 0.f}; float ss = 0.f;
    for (int ks = 0; ks < ksl; ks += 32) {
        const u32x4 aw = *(const u32x4*)(A0 + (size_t)l16 * lda + k0 + ks + 8 * g);
        const bf16x8 b = *(const bf16x8*)(B0 + (size_t)l16 * ldb + k0 + ks + 8 * g);
        acc = MFMA16(__builtin_bit_cast(bf16x8, aw), b, acc);
        if (SS) { float f[8]; unpack8(aw, f);
#pragma unroll
            for (int e = 0; e < 8; ++e) ss += f[e] * f[e]; }
    }
#pragma unroll
    for (int r = 0; r < 4; ++r) part[(wave * 16 + 4 * g + r) * 17 + l16] = acc[r];
    if (SS) { ss += __shfl_xor(ss, 16); ss += __shfl_xor(ss, 32); if (g == 0) ssp[wave * 16 + l16] = ss; }
    __syncthreads();
    val = 0.f; rowss = 0.f;
    if (tid < 256) { const int r = tid >> 4, c = tid & 15;
#pragma unroll
        for (int w = 0; w < 8; ++w) { val += part[(w * 16 + r) * 17 + c]; if (SS) rowss += ssp[w * 16 + r]; } }
    __syncthreads();
}
__device__ __forceinline__ void route_in(unsigned char* ws, const float* lb, int t, int col, float v) {
    const int cgp = col >> 9, cc = col & 511;
#pragma unroll
    for (int bb = 0; bb < 2; ++bb) {
        const size_t row = (size_t)bb * LSEQ + t;
        if (cgp >= 11) { ((bf16_t*)(ws + WS_GATE))[row * DFF + (col - 11 * 512)] = f2bf(sigmoidf_(v)); }
        else if (cgp == 2 || cgp == 7) { ((bf16_t*)(ws + (cgp == 2 ? WS_IT : WS_VT)))[((size_t)(bb * 512 + cc)) * LSEQ + t] = f2bf(v); }
        else {
            int dstg = 0; float o = v;
            if (cgp == 0) dstg = 0; else if (cgp == 1) dstg = 3; else if (cgp == 3) dstg = 4; else if (cgp == 4) dstg = 5; else if (cgp == 5) dstg = 1;
            else if (cgp == 6) dstg = 6; else if (cgp == 8) dstg = 7; else if (cgp == 9) dstg = 2; else dstg = 8;
            if (cgp == 1) { const float lbv = lb[cc], sg = sigmoidf_(v); ((float*)(ws + WS_LOGF))[row * BW + cc] = __logf(lbv + (1.0f - lbv) * sg); o = (1.0f - lbv) * (1.0f - sg); }
            else if (cgp == 3) o = sigmoidf_(v);
            else if (cgp == 5) o = v * 0.125f;
            ((bf16_t*)(ws + WS_MIX + (size_t)dstg * SZ_G))[row * BW + cc] = f2bf(o);
        }
    }
}
constexpr int TM0 = NVALID0;
__device__ __forceinline__ void skinny_p1(unsigned char* ws, const float* lb, LAS unsigned char* lds, int bid, int G, int tid, int wave, int lane) {
    const bf16_t* A0 = (const bf16_t*)(ws + WS_XN) + (size_t)TM0 * DM;
    for (int u = bid; u < INC / 16; u += G) {
        float val, rss; skinny_unit<true>(lds, A0, DM, (const bf16_t*)(ws + WS_WIN) + (size_t)u * 16 * DM, DM, DM, tid, wave, lane, val, rss);
        if (tid < 256) route_in(ws, lb, TM0 + (tid >> 4), u * 16 + (tid & 15), val * rsqrtf(rss * (1.0f / DM) + EPS));
    }
}
__device__ __forceinline__ void skinny_p3(unsigned char* ws, LAS unsigned char* lds, int bid, int G, int tid, int wave, int lane) {
    for (int u = bid; u < DM / 16; u += G) {
        const int r = tid >> 4, col = u * 16 + (tid & 15); float mixed = 0.f;
#pragma unroll 1
        for (int z = 0; z < 4; ++z) {
            const size_t ab = z == 0 ? WS_MIX : (z == 1 ? WS_POOLO : (z == 2 ? WS_MIX + SZ_G : WS_MIX + 2 * SZ_G));
            float val, rss; skinny_unit<false>(lds, (const bf16_t*)(ws + ab) + (size_t)TM0 * BW, BW, (const bf16_t*)(ws + WS_WBR) + (size_t)z * DM * BW + (size_t)u * 16 * BW, BW, BW, tid, wave, lane, val, rss);
            if (tid < 256) mixed += bf2f(((const bf16_t*)(ws + WS_GATE))[(size_t)(TM0 + r) * DFF + z * DM + col]) * val;
        }
        if (tid < 256) { const bf16_t o = f2bf(mixed); bf16_t* MB = (bf16_t*)(ws + WS_MIXEDB);
            MB[(size_t)(TM0 + r) * DM + col] = o; MB[(size_t)(LSEQ + TM0 + r) * DM + col] = o; }
    }
}
__device__ __forceinline__ void skinny_resid(unsigned char* ws, size_t aoff, int K, size_t woff, LAS unsigned char* lds, int bid, int G, int tid, int wave, int lane) {
    for (int u = bid; u < DM / 16; u += G) {
        float val, rss; skinny_unit<false>(lds, (const bf16_t*)(ws + aoff) + (size_t)TM0 * K, K, (const bf16_t*)(ws + woff) + (size_t)u * 16 * K, K, K, tid, wave, lane, val, rss);
        if (tid < 256) { const int r = tid >> 4, col = u * 16 + (tid & 15); float* X = (float*)(ws + WS_X); bf16_t* XN = (bf16_t*)(ws + WS_XN);
            const float xv = X[(size_t)(TM0 + r) * DM + col] + val; const bf16_t xb = f2bf(xv);
            X[(size_t)(TM0 + r) * DM + col] = xv; X[(size_t)(LSEQ + TM0 + r) * DM + col] = xv;
            XN[(size_t)(TM0 + r) * DM + col] = xb; XN[(size_t)(LSEQ + TM0 + r) * DM + col] = xb; }
    }
}
__device__ __forceinline__ void skinny_p5(unsigned char* ws, LAS unsigned char* lds, int bid, int G, int tid, int wave, int lane) {
    for (int u = bid; u < DFF / 16; u += G) {
        float val, rss; skinny_unit<true>(lds, (const bf16_t*)(ws + WS_XN) + (size_t)TM0 * DM, DM, (const bf16_t*)(ws + WS_WUP) + (size_t)u * 16 * DM, DM, DM, tid, wave, lane, val, rss);
        if (tid < 256) { const int r = tid >> 4, col = u * 16 + (tid & 15); const float a = fmaxf(val * rsqrtf(rss * (1.0f / DM) + EPS), 0.f); const bf16_t o = f2bf(a * a);
            bf16_t* H = (bf16_t*)(ws + WS_H); H[(size_t)(TM0 + r) * DFF + col] = o; H[(size_t)(LSEQ + TM0 + r) * DFF + col] = o; }
    }
}
__device__ __forceinline__ void zero_masked(unsigned char* ws, int gt, int NGT) {
    const u32x4 z4 = (u32x4){0u, 0u, 0u, 0u};
    for (int i = gt; i < 9 * 2 * NVALID0 * 64; i += NGT) { const int c = i & 63, rr = (i >> 6) % NVALID0, gb = (i >> 6) / NVALID0, bb = gb & 1, grp = gb >> 1;
        *(u32x4*)((bf16_t*)(ws + WS_MIX + (size_t)grp * SZ_G) + ((size_t)bb * LSEQ + rr) * BW + c * 8) = z4; }
    for (int i = gt; i < 2 * NVALID0 * 128; i += NGT) { const int c = i & 127, rr = (i >> 7) % NVALID0, bb = (i >> 7) / NVALID0;
        *(u32x4*)((float*)(ws + WS_LOGF) + ((size_t)bb * LSEQ + rr) * BW + c * 4) = z4; }
    for (int i = gt; i < 2 * 1024 * 14; i += NGT) { const int c = i % 14, ch = i / 14;
        *(u32x4*)((bf16_t*)(ws + WS_IT) + (size_t)ch * LSEQ + c * 8) = z4; }
}

constexpr int N_ATT = 16 * NCH, N_HGL = 2 * NCH * 4, N_POOL = 2 * NCH * 4, N_CONV = 2 * NCH;
__device__ __forceinline__ unsigned char* launder(unsigned char* q) { asm volatile("" : "+s"(q)); return q; }
#define PH_COMMON \
    int tid_ = threadIdx.x; asm volatile("" : "+v"(tid_)); int G_ = gridDim.x, bid_ = blockIdx.x; asm volatile("" : "+s"(G_), "+s"(bid_)); \
    const int tid = tid_, lane = tid & 63, wave = __builtin_amdgcn_readfirstlane(tid >> 6); \
    const int G = G_, bid = bid_, gw = bid * NWAVES + wave, NGW = G * NWAVES; unsigned char* ws = launder(p.ws); (void)lane; (void)gw; (void)NGW; (void)tid; (void)ws;

__device__ __forceinline__ void ph_pro(const Params& p, LAS unsigned char* lds, int l) { PH_COMMON
    if (l == 0) prologue_misc(p, gw, NGW, lane);
    zero_masked(ws, gw * 64 + lane, NGW * 64);
    convert_layer(p, l, lds, gw, NGW, wave, lane); }
__device__ __forceinline__ void ph_p1(const Params& p, LAS unsigned char* lds, int l) { PH_COMMON
    pg8::SchedPlain S; S.T.init(MROWS, INC); S.G = G; S.c = bid; S.A = (const char*)(ws + WS_XN); S.B = (const char*)(ws + WS_WIN); S.astep = (size_t)DM * 2; S.bstep = (size_t)256 * DM * 2;
    EpiIn E{ws, (const float*)(ws + WS_LB) + l * BW};
    pg8::gemm_phase(lds, tid, DM, DM, DM, S, E);
    skinny_p1(ws, (const float*)(ws + WS_LB) + l * BW, lds, bid, G, tid, wave, lane); }
__device__ __forceinline__ void ph_p2a(const Params& p, LAS unsigned char* lds, int l) { PH_COMMON
    for (int it = bid; it < N_ATT + N_HGL + N_POOL + N_CONV; it += G) {
        __syncthreads();
        if (it < N_ATT) attn_item(ws, lds, it, wave, lane);
        else if (it < N_ATT + N_HGL) hgrn2_local(ws, lds, it - N_ATT, tid, wave, lane);
        else if (it < N_ATT + N_HGL + N_POOL) pool_item(ws, l, it - N_ATT - N_HGL, wave, lane);
        else conv_item(ws, p.conv_w + (size_t)l * 3 * BW, it - N_ATT - N_HGL - N_POOL, tid);
    } }
__device__ __forceinline__ void ph_p2b(const Params& p, LAS unsigned char* lds, int l) { PH_COMMON
    hgrn2_scan(ws, gw * 64 + lane, NGW * 64); }
__device__ __forceinline__ void ph_p2c(const Params& p, LAS unsigned char* lds, int l) { PH_COMMON
    for (int it = bid; it < N_HGL; it += G) hgrn2_out(ws, p.hg_norm_g + l * BW, lds, it, tid, wave, lane); }
__device__ __forceinline__ void ph_p3(const Params& p, LAS unsigned char* lds, int l) { PH_COMMON
    pg8::SchedBranch S; S.T.init(MROWS, DM); S.G = G; S.c = bid;
    S.A0 = (const char*)(ws + WS_MIX); S.A1 = (const char*)(ws + WS_POOLO); S.A2 = (const char*)(ws + WS_MIX + SZ_G); S.A3 = (const char*)(ws + WS_MIX + 2 * SZ_G);
    S.B = (const char*)(ws + WS_WBR); S.astep = (size_t)BW * 2; S.bstep = (size_t)256 * BW * 2; S.bz = (size_t)DM * BW * 2;
    EpiBranch E{ws};
    pg8::gemm_phase(lds, tid, BW, BW, BW, S, E);
    skinny_p3(ws, lds, bid, G, tid, wave, lane); }
__device__ __forceinline__ void ph_p4(const Params& p, LAS unsigned char* lds, int l) { PH_COMMON
    pg8::SchedPlain S; S.T.init(MROWS, DM); S.G = G; S.c = bid; S.A = (const char*)(ws + WS_MIXEDB); S.B = (const char*)(ws + WS_WO); S.astep = (size_t)DM * 2; S.bstep = (size_t)256 * DM * 2;
    EpiResid E{ws, (float*)(ws + WS_ST2)};
    pg8::gemm_phase(lds, tid, DM, DM, DM, S, E);
    skinny_resid(ws, WS_MIXEDB, DM, WS_WO, lds, bid, G, tid, wave, lane); }
__device__ __forceinline__ void ph_p5(const Params& p, LAS unsigned char* lds, int l) { PH_COMMON
    pg8::SchedPlain S; S.T.init(MROWS, DFF); S.G = G; S.c = bid; S.A = (const char*)(ws + WS_XN); S.B = (const char*)(ws + WS_WUP); S.astep = (size_t)DM * 2; S.bstep = (size_t)256 * DM * 2;
    EpiUp E{ws};
    pg8::gemm_phase(lds, tid, DM, DM, DM, S, E);
    skinny_p5(ws, lds, bid, G, tid, wave, lane); }
__device__ __forceinline__ void ph_p6(const Params& p, LAS unsigned char* lds, int l) { PH_COMMON
    pg8::SchedPlain S; S.T.init(MROWS, DM); S.G = G; S.c = bid; S.A = (const char*)(ws + WS_H); S.B = (const char*)(ws + WS_WDN); S.astep = (size_t)DFF * 2; S.bstep = (size_t)256 * DFF * 2;
    EpiResid E{ws, (float*)(ws + WS_ST1)};
    pg8::gemm_phase(lds, tid, DFF, DFF, DFF, S, E);
    skinny_resid(ws, WS_H, DFF, WS_WDN, lds, bid, G, tid, wave, lane); }
__device__ __forceinline__ void ph_fin(const Params& p, LAS unsigned char* lds, int l) { PH_COMMON
    final_norm(p, gw, NGW, lane); }

#ifndef MEGA
#define MEGA 1
#endif
#ifdef DIAG
__global__ void k_chk(const unsigned char* base, size_t nbytes, int isf32, int code, unsigned* flag) {
    const size_t n = nbytes / 4; const unsigned* w = (const unsigned*)base; bool bad = false;
    for (size_t i = (size_t)blockIdx.x * blockDim.x + threadIdx.x; i < n; i += (size_t)gridDim.x * blockDim.x) {
        const unsigned u = w[i];
        if (isf32) bad |= (u & 0x7F800000u) == 0x7F800000u;
        else bad |= ((u & 0x7F80u) == 0x7F80u) || ((u & 0x7F800000u) == 0x7F800000u);
    }
    if (bad) atomicMin(flag, (unsigned)code);
}
__global__ void k_flaginit(unsigned* flag) { if (threadIdx.x == 0 && blockIdx.x == 0) *flag = 99u; }
__global__ void k_flagout(const unsigned* flag, float* out, size_t n) {
    const unsigned f = *flag; if (f == 99u) return;
    for (size_t i = (size_t)blockIdx.x * blockDim.x + threadIdx.x; i < n; i += (size_t)gridDim.x * blockDim.x) out[i] = (float)f;
}

#endif
#define XB_TMO      128
#define XB_XCNT(j)  (256  + 64 * (j))
#define XB_XSUB(j)  (1280 + 64 * (j))
#define XB_XGEN(j)  (2304 + 64 * (j))
#define XB_TOP      3328
#define XB_TOPGEN   3392
#define XCD_BAR_WORDS 3456
#define XB_SPIN_CAP (1u << 22)
__device__ __forceinline__ unsigned xb_ld(unsigned* p)              { return __hip_atomic_load(p, __ATOMIC_RELAXED, __HIP_MEMORY_SCOPE_AGENT); }
__device__ __forceinline__ unsigned xb_add(unsigned* p, unsigned v) { return __hip_atomic_fetch_add(p, v, __ATOMIC_RELAXED, __HIP_MEMORY_SCOPE_AGENT); }
__device__ __forceinline__ unsigned xb_xcc_id() { return (unsigned)__builtin_amdgcn_s_getreg((3 << 11) | 20) & 0xFu; }
#define XB_SPIN(cond, bar) do { unsigned _sp = 0; while (cond) { __builtin_amdgcn_s_sleep(1); \
    if ((++_sp & 255u) == 0u) { if (xb_ld(&(bar)[XB_TMO])) break; if (_sp > XB_SPIN_CAP) { atomicAdd(&(bar)[XB_TMO], 1u); break; } } } } while (0)
struct XcdBarrier { unsigned* bar; unsigned x; volatile LAS unsigned* st; };
__device__ __forceinline__ XcdBarrier xcd_barrier_post(unsigned* bar, volatile LAS unsigned* st) {
    XcdBarrier b; b.bar = bar; b.x = xb_xcc_id(); b.st = st;
    if (threadIdx.x == 0) (void)xb_add(&bar[XB_XCNT(b.x)], 1u);
    return b;
}
__device__ __forceinline__ void xcd_barrier_complete(unsigned* bar, unsigned x, unsigned& nloc, unsigned& nx) {
    const unsigned G = gridDim.x * gridDim.y * gridDim.z;
    unsigned sum, cnt, mine, sp = 0u;
    for (;;) {
        sum = 0u; cnt = 0u; mine = 0u;
#pragma unroll
        for (unsigned j = 0; j < 16; ++j) { const unsigned c = xb_ld(&bar[XB_XCNT(j)]); sum += c; cnt += (c > 0u) ? 1u : 0u; mine = (j == x) ? c : mine; }
        if (sum == G) break;
        __builtin_amdgcn_s_sleep(1);
        if ((++sp & 255u) == 0u) { if (xb_ld(&bar[XB_TMO])) break; if (sp > XB_SPIN_CAP) { atomicAdd(&bar[XB_TMO], 1u); break; } }
    }
    nloc = mine > 0u ? mine : 1u; nx = cnt > 0u ? cnt : 1u;
}
__device__ __forceinline__ void xcd_barrier(const XcdBarrier& b) {
    asm volatile("s_waitcnt vmcnt(0)" ::: "memory");
    __syncthreads();
    if (threadIdx.x == 0) {
        unsigned* bar = b.bar;
        __builtin_amdgcn_s_waitcnt(0);
        unsigned nloc = b.st[0], nx = b.st[1];
        if (nloc == 0u) { xcd_barrier_complete(bar, b.x, nloc, nx); b.st[0] = nloc; b.st[1] = nx; }
        const unsigned old = xb_add(&bar[XB_XSUB(b.x)], 1u);
        const unsigned gen = old / nloc;
        if (old + 1u == (gen + 1u) * nloc) {
            __builtin_amdgcn_fence(__ATOMIC_RELEASE, "agent");
            asm volatile("s_waitcnt vmcnt(0)" ::: "memory");
            const unsigned og = xb_add(&bar[XB_TOP], 1u);
            const unsigned tg = og / nx;
            if (og + 1u == (tg + 1u) * nx) xb_add(&bar[XB_TOPGEN], 1u);
            else XB_SPIN(xb_ld(&bar[XB_TOPGEN]) == tg, bar);
            __builtin_amdgcn_fence(__ATOMIC_ACQUIRE, "agent");
            xb_add(&bar[XB_XGEN(b.x)], 1u);
            asm volatile("s_waitcnt vmcnt(0)" ::: "memory");
        } else {
            XB_SPIN(xb_ld(&bar[XB_XGEN(b.x)]) == gen, bar);
            __builtin_amdgcn_fence(__ATOMIC_ACQUIRE, "agent");
            asm volatile("s_waitcnt vmcnt(0)" ::: "memory");
        }
    }
    __syncthreads();
}

#if MEGA
__global__ void __launch_bounds__(NT, 2) fwd_megakernel(Params p) {
    extern __shared__ __attribute__((aligned(16))) unsigned char lds_raw[];
    LAS unsigned char* lds = (LAS unsigned char*)lds_raw;
    cg::grid_group grid = cg::this_grid();
    volatile LAS unsigned* bst = (volatile LAS unsigned*)(lds + 140000);
    if (threadIdx.x == 0) { bst[0] = 0u; bst[1] = 0u; }
    __syncthreads();
    const XcdBarrier bar = xcd_barrier_post((unsigned*)(p.ws + WS_CTL), bst);
#pragma unroll 1
    for (int ph = 0; ph < 1 + DEPTH * 9; ++ph) {
        const int l = ph == 0 ? 0 : (ph - 1) / 9, k = ph == 0 ? 0 : (ph - 1) % 9;
        if (ph == 0) ph_pro(p, lds, 0);
        else if (k == 0) ph_p1(p, lds, l);
        else if (k == 1) ph_p2a(p, lds, l);
        else if (k == 2) ph_p2b(p, lds, l);
        else if (k == 3) ph_p2c(p, lds, l);
        else if (k == 4) ph_p3(p, lds, l);
        else if (k == 5) ph_p4(p, lds, l);
        else if (k == 6) ph_p5(p, lds, l);
        else if (k == 7) ph_p6(p, lds, l);
        else { if (l + 1 < DEPTH) ph_pro(p, lds, l + 1); }
        if (ph == 0) grid.sync(); else xcd_barrier(bar);
    }
    ph_fin(p, lds, 0);
}
#else
#define MKK(NAME, FN) __global__ void __launch_bounds__(NT, 2) NAME(Params p, int l) { \
    extern __shared__ __attribute__((aligned(16))) unsigned char lds_raw[]; FN(p, (LAS unsigned char*)lds_raw, l); }
MKK(k_pro, ph_pro) MKK(k_p1, ph_p1) MKK(k_p2a, ph_p2a) MKK(k_p2b, ph_p2b) MKK(k_p2c, ph_p2c) MKK(k_p3, ph_p3) MKK(k_p4, ph_p4) MKK(k_p5, ph_p5) MKK(k_p6, ph_p6) MKK(k_fin, ph_fin)
__device__ __forceinline__ void ph_poolonly(const Params& p, LAS unsigned char* lds, int l) { PH_COMMON
    for (int it = bid; it < N_POOL; it += G) pool_item(ws, l, it, wave, lane); }
MKK(k_poolonly, ph_poolonly)
#endif

extern "C" void kernel_launch(void* const* d_in, const int* in_sizes, int n_in, void* d_out, int out_size, void* d_ws, size_t ws_size, hipStream_t stream) {
    static int grid = 0;
    if (grid == 0) {
        int dev = 0, cus = 0;
        (void)hipGetDevice(&dev); (void)hipDeviceGetAttribute(&cus, hipDeviceAttributeMultiprocessorCount, dev);
#if MEGA
        int per = 0;
        (void)hipFuncSetAttribute((const void*)fwd_megakernel, hipFuncAttributeMaxDynamicSharedMemorySize, LDS_BYTES);
        (void)hipOccupancyMaxActiveBlocksPerMultiprocessor(&per, (const void*)fwd_megakernel, NT, LDS_BYTES);
        if (per < 1) per = 1;
        grid = cus * per;
#else
        const void* ks[] = {(const void*)k_pro, (const void*)k_p1, (const void*)k_p2a, (const void*)k_p2b, (const void*)k_p2c, (const void*)k_p3, (const void*)k_p4, (const void*)k_p5, (const void*)k_p6, (const void*)k_fin};
        for (int i = 0; i < 10; ++i) (void)hipFuncSetAttribute(ks[i], hipFuncAttributeMaxDynamicSharedMemorySize, LDS_BYTES);
        grid = cus;
#endif
        if (n_in != 15 || ws_size < WS_END) { fprintf(stderr, "kernel_launch: unexpected n_in %d / ws %zu (need %zu)\n", n_in, ws_size, (size_t)WS_END); }
    }
    Params p{};
    p.x = (const float*)d_in[0]; p.meta = (const float*)d_in[1]; p.lb_logits = (const float*)d_in[2]; p.norm1_g = (const float*)d_in[3]; p.w_in = (const float*)d_in[4];
    p.hg_norm_g = (const float*)d_in[5]; p.pool_w = (const float*)d_in[6]; p.pool_scale = (const float*)d_in[7]; p.conv_w = (const float*)d_in[8]; p.w_branch = (const float*)d_in[9];
    p.w_o = (const float*)d_in[10]; p.norm2_g = (const float*)d_in[11]; p.w_up = (const float*)d_in[12]; p.w_down = (const float*)d_in[13]; p.final_g = (const float*)d_in[14];
    p.out = (float*)d_out; p.ws = (unsigned char*)d_ws;
#if MEGA
    (void)hipMemsetAsync((char*)d_ws + WS_CTL, 0, 16384, stream);
    void* args[] = {&p};
    hipError_t e = hipLaunchCooperativeKernel((void*)fwd_megakernel, dim3(grid), dim3(NT), args, LDS_BYTES, stream);
    if (e != hipSuccess) fprintf(stderr, "cooperative launch failed: %s (grid %d)\n", hipGetErrorString(e), grid);
#else
#define LK(K, L) hipLaunchKernelGGL(K, dim3(grid), dim3(NT), LDS_BYTES, stream, p, (int)(L))
#ifdef DIAG
    unsigned char* W = (unsigned char*)d_ws; unsigned* flag = (unsigned*)(W + WS_END + 4096);
#define CHK(off, bytes, f32, code) hipLaunchKernelGGL(k_chk, dim3(1024), dim3(256), 0, stream, (const unsigned char*)(W + (off)), (size_t)(bytes), (int)(f32), (int)(code), flag)
    hipLaunchKernelGGL(k_flaginit, dim3(1), dim3(64), 0, stream, flag);
    LK(k_pro, 0);
    CHK(WS_X, (size_t)ROWS * DM * 4, 1, 1); CHK(WS_XN, (size_t)ROWS * DM * 2, 0, 1); CHK(WS_WIN, WS_X - WS_WIN, 0, 1); CHK(WS_LB, WS_DEC, 1, 1); CHK(WS_ST1, (size_t)ROWS * 64, 1, 1);
    LK(k_p1, 0);
    CHK(WS_MIX, 9 * SZ_G, 0, 2); CHK(WS_IT, 2 * SZ_G, 0, 3); CHK(WS_GATE, (size_t)ROWS * DFF * 2, 0, 4); CHK(WS_LOGF, (size_t)ROWS * BW * 4, 1, 5);
    CHK(WS_PWT, 4 * 4 * 128 * 128 * 2, 0, 1);
    LK(k_poolonly, 0);
    CHK(WS_POOLO, SZ_G, 0, 6);
    LK(k_p2a, 0);
    CHK(WS_POOLO, SZ_G, 0, 16); CHK(WS_DS, (size_t)ROWS * BW * 4, 1, 7); CHK(WS_LOGF, (size_t)ROWS * BW * 4, 1, 8); CHK(WS_MIX + SZ_G, 2 * SZ_G, 0, 9);
    LK(k_p2b, 0);
    CHK(WS_SPREV, SZ_G, 0, 10);
    LK(k_p2c, 0);
    CHK(WS_MIX, SZ_G, 0, 11);
    LK(k_p3, 0);
    CHK(WS_MIXEDB, 2 * SZ_G, 0, 12);
    LK(k_p4, 0);
    CHK(WS_X, (size_t)ROWS * DM * 4, 1, 13);
    LK(k_p5, 0);
    CHK(WS_H, (size_t)ROWS * DFF * 2, 0, 14);
    LK(k_p6, 0);
    CHK(WS_X, (size_t)ROWS * DM * 4, 1, 15);
    LK(k_fin, 0);
    hipLaunchKernelGGL(k_flagout, dim3(1024), dim3(256), 0, stream, (const unsigned*)flag, (float*)d_out, (size_t)BATCH * SEQ * DM);
#else
    LK(k_pro, 0);
    for (int l = 0; l < DEPTH; ++l) {
        if (l > 0) LK(k_pro, l);
        LK(k_p1, l); LK(k_p2a, l); LK(k_p2b, l); LK(k_p2c, l); LK(k_p3, l); LK(k_p4, l); LK(k_p5, l); LK(k_p6, l);
    }
    LK(k_fin, 0);
#endif
#endif
}
```

```cpp
#define MEGA 1
#include <hip/hip_runtime.h>
#include <hip/hip_cooperative_groups.h>
#include <cstdio>
#include <cstdint>
namespace cg = cooperative_groups;

#define LAS __attribute__((address_space(3)))
typedef unsigned short bf16_t;
typedef short bf16x8 __attribute__((ext_vector_type(8)));
typedef float f32x4 __attribute__((ext_vector_type(4)));
typedef float f32x2 __attribute__((ext_vector_type(2)));
typedef unsigned u32x4 __attribute__((ext_vector_type(4)));
typedef unsigned u32x2 __attribute__((ext_vector_type(2)));

constexpr int DM = 1024, BATCH = 2, SEQ = 8192, DEPTH = 4, FRONT = 128, NVALID0 = 112, LSEQ = 8320, ROWS = BATCH * LSEQ;
constexpr int BW = 512, INC = 9728, DFF = 4096, NCH = 65;
constexpr float EPS = 1e-6f;
constexpr int NT = 512, NWAVES = 8;
constexpr int PF = DFF + 64;
constexpr int MROWS = BATCH * SEQ;

constexpr size_t al(size_t x) { return (x + 4095) & ~(size_t)4095; }
constexpr size_t SZ_G = (size_t)ROWS * BW * 2;
constexpr size_t WS_LB = 0;
constexpr size_t WS_PWT = al(WS_LB + 4 * 512 * 4);
constexpr size_t WS_DEC = al(WS_PWT + 4 * 4 * 128 * 128 * 2);
constexpr size_t WS_ST1 = al(WS_DEC + 2 * 65 * 4 * 128 * 4);
constexpr size_t WS_ST2 = al(WS_ST1 + (size_t)ROWS * 16 * 4);
constexpr size_t WS_WIN = al(WS_ST2 + (size_t)ROWS * 16 * 4);
constexpr size_t WS_WBR = al(WS_WIN + (size_t)INC * DM * 2);
constexpr size_t WS_WO = al(WS_WBR + (size_t)4 * DM * BW * 2);
constexpr size_t WS_WUP = al(WS_WO + (size_t)DM * DM * 2);
constexpr size_t WS_WDN = al(WS_WUP + (size_t)DFF * DM * 2);
constexpr size_t WS_X = al(WS_WDN + (size_t)PF * DM * 2);
constexpr size_t WS_XN = al(WS_X + (size_t)ROWS * DM * 4);
constexpr size_t WS_MIX = al(WS_XN + (size_t)ROWS * DM * 2);
constexpr size_t WS_MIXEDB = WS_MIX + 3 * SZ_G;
constexpr size_t WS_POOLO = al(WS_MIX + 9 * SZ_G);
constexpr size_t WS_IT = al(WS_POOLO + SZ_G);
constexpr size_t WS_VT = al(WS_IT + SZ_G);
constexpr size_t WS_GATE = al(WS_VT + SZ_G);
constexpr size_t WS_H = WS_GATE;
constexpr size_t WS_LOGF = al(WS_GATE + (size_t)ROWS * PF * 2);
constexpr size_t WS_DS = WS_LOGF + (size_t)ROWS * BW * 4;
constexpr size_t WS_MIXEDF = WS_LOGF;
constexpr size_t WS_SPREV = al(WS_DS + (size_t)ROWS * BW * 4);
constexpr size_t WS_CTL = al(WS_SPREV + SZ_G);
constexpr size_t WS_W2 = WS_CTL + 16384;
constexpr size_t W2_OFF = WS_W2 - WS_WBR;
constexpr size_t WS_END = WS_W2 + (WS_X - WS_WBR);
static_assert(WS_DS + (size_t)ROWS * BW * 4 == WS_MIXEDF + (size_t)ROWS * DM * 4, "MIXEDF overlay");

constexpr int LDS_BYTES = 147456;

typedef __bf16 bf16x2_t __attribute__((ext_vector_type(2)));
__device__ __forceinline__ unsigned cvt_pk_bf16(float lo, float hi) { const f32x2 v = {lo, hi}; return __builtin_bit_cast(unsigned, __builtin_convertvector(v, bf16x2_t)); }
__device__ __forceinline__ float bflo(unsigned w) { return __uint_as_float(w << 16); }
__device__ __forceinline__ float bfhi(unsigned w) { return __uint_as_float(w & 0xffff0000u); }
__device__ __forceinline__ float bf2f(bf16_t u) { return __uint_as_float(((unsigned)u) << 16); }
__device__ __forceinline__ bf16_t f2bf(float f) { return (bf16_t)(cvt_pk_bf16(f, 0.f) & 0xffffu); }
__device__ __forceinline__ float sigmoidf_(float v) { return __builtin_amdgcn_rcpf(1.0f + __expf(-v)); }
__device__ __forceinline__ float wave_sum(float v) {
#pragma unroll
    for (int o = 1; o < 64; o <<= 1) v += __shfl_xor(v, o);
    return v;
}
__device__ __forceinline__ void unpack8(const u32x4 w, float (&f)[8]) {
    f[0] = bflo(w.x); f[1] = bfhi(w.x); f[2] = bflo(w.y); f[3] = bfhi(w.y); f[4] = bflo(w.z); f[5] = bfhi(w.z); f[6] = bflo(w.w); f[7] = bfhi(w.w);
}
__device__ __forceinline__ bf16x8 pack8(const float (&f)[8]) {
    u32x4 w; w.x = cvt_pk_bf16(f[0], f[1]); w.y = cvt_pk_bf16(f[2], f[3]); w.z = cvt_pk_bf16(f[4], f[5]); w.w = cvt_pk_bf16(f[6], f[7]);
    return __builtin_bit_cast(bf16x8, w);
}
#define MFMA16(a, b, c) __builtin_amdgcn_mfma_f32_16x16x32_bf16((a), (b), (c), 0, 0, 0)

struct Params {
    const float *x, *meta, *lb_logits, *norm1_g, *w_in, *hg_norm_g, *pool_w, *pool_scale, *conv_w, *w_branch, *w_o, *norm2_g, *w_up, *w_down, *final_g;
    float* out; unsigned char* ws;
};
namespace pg8 {
constexpr int BM = 256, BK = 64, HALF = 128, HTB = HALF * BK * 2, STAGE_BYTES = 8 * HTB, NXCD = 8, WGM = 8;
__device__ __forceinline__ int lds_byte(int r, int c) { const int st = (r >> 4) * 2 + (c >> 5), rr = r & 15, cc = c & 31, ob = rr * 64 + cc * 2; return st * 1024 + (ob ^ (((ob >> 9) & 1) << 5)); }
__device__ __forceinline__ void stage_rc(int b, int& R, int& C) { const int st = b / 1024, sb = b % 1024, swz = sb ^ (((sb >> 9) & 1) << 5); R = (st >> 1) * 16 + swz / 64; C = (st & 1) * 32 + (swz % 64) / 2; }
__device__ __forceinline__ int perm32(int rho) { const int n = rho >> 4, i = rho & 15; return 8 * (i >> 2) + 4 * n + (i & 3); }

struct Unit { int pm, pn, z; const char* a; const char* b; };
__device__ __forceinline__ int rowbase(int pm) { return (pm >> 5) * LSEQ + FRONT + (pm & 31) * 256; }

struct TileOrder {
    int nM, nN, nwg;
    __device__ __forceinline__ void init(int M, int N) { nM = M / BM; nN = N / BM; nwg = nM * nN; }
    __device__ __forceinline__ bool tile(long L, int& pm, int& pn) const {
        if (L >= nwg) return false;
        int wgid = (int)L; { const int q = nwg / NXCD, r = nwg % NXCD, xcd = wgid % NXCD, off = wgid / NXCD; wgid = (xcd < r ? xcd * (q + 1) : r * (q + 1) + (xcd - r) * q) + off; }
        const int nig = WGM * nN, gid = wgid / nig, fm = gid * WGM, gsz = (nM - fm) < WGM ? (nM - fm) : WGM;
        pm = fm + ((wgid % nig) % gsz); pn = (wgid % nig) / gsz; return true;
    }
};
struct SchedPlain {
    TileOrder T; int G, c; const char* A; const char* B; size_t astep, bstep;
    __device__ __forceinline__ bool next(int i, Unit& u) const {
        if (!T.tile((long)i * G + c, u.pm, u.pn)) return false;
        u.z = 0; u.a = A + (size_t)rowbase(u.pm) * astep; u.b = B + (size_t)u.pn * bstep; return true;
    }
};
struct SchedBranch {
    TileOrder T; int G, c; const char *A0, *A1, *A2, *A3; const char* B; size_t astep, bstep, bz;
    __device__ __forceinline__ bool next(int i, Unit& u) const {
        if (!T.tile((long)(i >> 2) * G + c, u.pm, u.pn)) return false;
        u.z = i & 3; const char* ab = u.z == 0 ? A0 : (u.z == 1 ? A1 : (u.z == 2 ? A2 : A3));
        u.a = ab + (size_t)rowbase(u.pm) * astep; u.b = B + (size_t)u.z * bz + (size_t)u.pn * bstep; return true;
    }
};

template <class Epi, class Sched>
__device__ __forceinline__ void gemm_phase(LAS unsigned char* lds, const int tid, const int lda, const int ldb, const int K, const Sched& S, const Epi& E) {
    const int wid = __builtin_amdgcn_readfirstlane(tid >> 6), lane = tid & 63, wr = wid >> 2, wc = wid & 3, fr = lane & 15, fq = lane >> 4;
    const int nt = K / BK;
    unsigned voffA[2], voffB[2];
#pragma unroll
    for (int i = 0; i < 2; ++i) { int R, C; stage_rc(tid * 16 + i * 8192, R, C); const int Rb = Epi::PERM ? ((R & ~31) + perm32(R & 31)) : R;
        voffA[i] = (unsigned)(R * lda + C) * 2u; voffB[i] = (unsigned)(Rb * ldb + C) * 2u; }
    const size_t kstep = (size_t)(BK * 2);
    const size_t hstepA = (size_t)HALF * lda * 2, hstepB = (size_t)HALF * ldb * 2;
    const unsigned ldsw = (unsigned)wid * 1024u;
    const int aoff = lds_byte(wr * 64 + fr, fq * 8), boff = lds_byte(wc * 32 + fr, fq * 8);
#define PG8_SA(b, h) (((b) * 2 + (h)) * HTB)
#define PG8_SB(b, h) ((4 + (b) * 2 + (h)) * HTB)
#define PG8_STAGE(bufoff, gbase, voff) do { _Pragma("unroll") for (int _i = 0; _i < 2; ++_i) \
        __builtin_amdgcn_global_load_lds((const unsigned*)((const char*)(gbase) + (voff)[_i]), (LAS unsigned*)(lds + (bufoff) + ldsw + _i * 8192), 16, 0, 0); } while (0)
#define PG8_LDA(dst, b, h) do { _Pragma("unroll") for (int m = 0; m < 4; ++m) _Pragma("unroll") for (int k = 0; k < 2; ++k) dst[m][k] = *(const LAS bf16x8*)(lds + PG8_SA(b, h) + aoff + m * 2048 + k * 1024); } while (0)
#define PG8_LDB(dst, b, h) do { _Pragma("unroll") for (int n = 0; n < 2; ++n) _Pragma("unroll") for (int k = 0; k < 2; ++k) dst[n][k] = *(const LAS bf16x8*)(lds + PG8_SB(b, h) + boff + n * 2048 + k * 1024); } while (0)
#define PG8_MMA(ai, bj, At, Bt) do { __builtin_amdgcn_s_setprio(1); _Pragma("unroll") for (int m = 0; m < 4; ++m) _Pragma("unroll") for (int n = 0; n < 2; ++n) _Pragma("unroll") for (int k = 0; k < 2; ++k) \
        acc[ai][bj][m][n] = __builtin_amdgcn_mfma_f32_16x16x32_bf16(Bt[n][k], At[m][k], acc[ai][bj][m][n], 0, 0, 0); __builtin_amdgcn_s_setprio(0); } while (0)
#define PG8_WAIT_V(n) asm volatile("s_waitcnt vmcnt(" #n ")" ::: "memory")
#define PG8_WAIT_L(n) asm volatile("s_waitcnt lgkmcnt(" #n ")" ::: "memory")
#define PG8_BAR __builtin_amdgcn_s_barrier()
#define PG8_SCHED __builtin_amdgcn_sched_barrier(0)
    Unit cur, nxt; int ui = 0;
    if (!S.next(0, cur)) return;
    f32x4 acc[2][2][4][2];
#pragma unroll
    for (int a = 0; a < 2; ++a)
#pragma unroll
        for (int b = 0; b < 2; ++b)
#pragma unroll
            for (int m = 0; m < 4; ++m)
#pragma unroll
                for (int n = 0; n < 2; ++n) acc[a][b][m][n] = (f32x4){0.f, 0.f, 0.f, 0.f};
    bf16x8 At[4][2], B0[2][2], B1[2][2];
    const char* cA = cur.a; const char* cB = cur.b;
    PG8_STAGE(PG8_SB(0, 0), cB, voffB); PG8_STAGE(PG8_SB(0, 1), cB + hstepB, voffB); PG8_STAGE(PG8_SA(0, 0), cA, voffA); PG8_STAGE(PG8_SA(0, 1), cA + hstepA, voffA);
    if (wr == 1) PG8_BAR;
    PG8_WAIT_V(2); PG8_BAR;
    PG8_STAGE(PG8_SB(1, 0), cB + kstep, voffB); PG8_STAGE(PG8_SA(1, 0), cA + kstep, voffA); PG8_STAGE(PG8_SB(1, 1), cB + hstepB + kstep, voffB);
    PG8_WAIT_V(6); PG8_BAR;
    for (;;) {
        const bool has_next = S.next(ui + 1, nxt);
        const char* nA = has_next ? nxt.a : cA; const char* nB = has_next ? nxt.b : cB;
        for (int t = 0; t < nt; t += 2) {
            const bool last = (t == nt - 2);
            const char* a1 = cA + (size_t)(t + 1) * kstep;
            const char* a2 = last ? nA : cA + (size_t)(t + 2) * kstep; const char* b2 = last ? nB : cB + (size_t)(t + 2) * kstep;
            const char* a3 = a2 + kstep; const char* b3 = b2 + kstep;
            PG8_LDB(B0, 0, 0); PG8_LDB(B1, 0, 1); PG8_SCHED; PG8_LDA(At, 0, 0); PG8_STAGE(PG8_SA(1, 1), a1 + hstepA, voffA);
            PG8_WAIT_V(8); PG8_WAIT_L(0); PG8_BAR; PG8_MMA(0, 0, At, B0); PG8_MMA(0, 1, At, B1); PG8_BAR; PG8_SCHED;
            PG8_LDA(At, 0, 1); PG8_STAGE(PG8_SB(0, 0), b2, voffB); PG8_STAGE(PG8_SB(0, 1), b2 + hstepB, voffB); PG8_STAGE(PG8_SA(0, 0), a2, voffA);
            PG8_WAIT_V(8); PG8_WAIT_L(0); PG8_BAR; PG8_MMA(1, 0, At, B0); PG8_MMA(1, 1, At, B1); PG8_BAR; PG8_SCHED;
            PG8_LDB(B0, 1, 0); PG8_LDB(B1, 1, 1); PG8_SCHED; PG8_LDA(At, 1, 0); PG8_STAGE(PG8_SA(0, 1), a2 + hstepA, voffA);
            PG8_WAIT_V(8); PG8_WAIT_L(0); PG8_BAR; PG8_MMA(0, 0, At, B0); PG8_MMA(0, 1, At, B1); PG8_BAR; PG8_SCHED;
            PG8_LDA(At, 1, 1); PG8_STAGE(PG8_SB(1, 0), b3, voffB); PG8_STAGE(PG8_SB(1, 1), b3 + hstepB, voffB); PG8_STAGE(PG8_SA(1, 0), a3, voffA);
            PG8_WAIT_V(8); PG8_WAIT_L(0); PG8_BAR; PG8_MMA(1, 0, At, B0); PG8_MMA(1, 1, At, B1); PG8_BAR; PG8_SCHED;
        }
        if (wr == 0) PG8_BAR;
        E(acc, cur, wr, wc, fr, fq);
        if (!has_next) break;
        if (!Epi::KEEP || cur.z == 3)
#pragma unroll
        for (int a = 0; a < 2; ++a)
#pragma unroll
            for (int b = 0; b < 2; ++b)
#pragma unroll
                for (int m = 0; m < 4; ++m)
#pragma unroll
                    for (int n = 0; n < 2; ++n) acc[a][b][m][n] = (f32x4){0.f, 0.f, 0.f, 0.f};
        cur = nxt; cA = nA; cB = nB; ++ui;
        if (wr == 1) PG8_BAR;
    }
    PG8_WAIT_V(0);
    PG8_BAR;
#undef PG8_SA
#undef PG8_SB
#undef PG8_STAGE
#undef PG8_LDA
#undef PG8_LDB
#undef PG8_MMA
#undef PG8_WAIT_V
#undef PG8_WAIT_L
#undef PG8_BAR
#undef PG8_SCHED
}
}
using pg8::Unit;

__device__ __forceinline__ float row_rstd(const float* st, int row) {
    const f32x4* p = (const f32x4*)(st + (size_t)row * 16);
    const f32x4 a = p[0], b = p[1], c = p[2], d = p[3];
    const float s = ((a.x + a.y) + (a.z + a.w)) + ((b.x + b.y) + (b.z + b.w)) + ((c.x + c.y) + (c.z + c.w)) + ((d.x + d.y) + (d.z + d.w));
    return rsqrtf(s * (1.0f / DM) + EPS);
}

struct EpiIn {
    static constexpr bool PERM = true, KEEP = false;
    unsigned char* ws; const float* lb;
    __device__ __forceinline__ void operator()(f32x4 (&acc)[2][2][4][2], const Unit& u, int wr, int wc, int fr, int fq) const {
        const float* st = (const float*)(ws + WS_ST1);
        const int cgp = u.pn >> 1;
        const int ccb = (u.pn & 1) * 256 + wc * 32 + 8 * fq;
        int dstg = -1;
        if (cgp == 0) dstg = 0; else if (cgp == 1) dstg = 3; else if (cgp == 3) dstg = 4; else if (cgp == 4) dstg = 5; else if (cgp == 5) dstg = 1;
        else if (cgp == 6) dstg = 6; else if (cgp == 8) dstg = 7; else if (cgp == 9) dstg = 2; else if (cgp == 10) dstg = 8;
#pragma unroll
        for (int ai = 0; ai < 2; ++ai) {
            float rsv[4];
#pragma unroll
            for (int q = 0; q < 4; ++q) rsv[q] = row_rstd(st, pg8::rowbase(u.pm) + ai * 128 + wr * 64 + q * 16 + fr);
#pragma unroll
            for (int m = 0; m < 4; ++m) {
                const int row = pg8::rowbase(u.pm) + ai * 128 + wr * 64 + m * 16 + fr;
                const float rs = rsv[m];
                const int bb = row >= LSEQ ? 1 : 0, t = row - bb * LSEQ;
#pragma unroll
                for (int bj = 0; bj < 2; ++bj) {
                    const int cc = ccb + bj * 128;
                    float v[8];
#pragma unroll
                    for (int e = 0; e < 4; ++e) { v[e] = acc[ai][bj][m][0][e] * rs; v[4 + e] = acc[ai][bj][m][1][e] * rs; }
                    if (cgp >= 11) {
#pragma unroll
                        for (int e = 0; e < 8; ++e) v[e] = sigmoidf_(v[e]);
                        bf16_t* dst = (bf16_t*)(ws + WS_GATE) + (size_t)row * PF + (cgp - 11) * 512 + cc;
                        *(u32x4*)dst = __builtin_bit_cast(u32x4, pack8(v));
                    } else if (cgp == 2 || cgp == 7) {
                        bf16_t* dst = (bf16_t*)(ws + (cgp == 2 ? WS_IT : WS_VT)) + ((size_t)(bb * 512 + cc)) * LSEQ + t;
#pragma unroll
                        for (int e = 0; e < 8; ++e) dst[(size_t)e * LSEQ] = f2bf(v[e]);
                    } else {
                        if (cgp == 1) {
                            const bool valid = t >= NVALID0;
                            const f32x4 l0 = *(const f32x4*)(lb + cc), l1 = *(const f32x4*)(lb + cc + 4);
                            float lf[8];
#pragma unroll
                            for (int e = 0; e < 8; ++e) { const float lbv = e < 4 ? l0[e] : l1[e - 4]; const float sg = sigmoidf_(v[e]);
                                lf[e] = valid ? __logf(lbv + (1.0f - lbv) * sg) : 0.f; v[e] = valid ? (1.0f - lbv) * (1.0f - sg) : 0.f; }
                            float* ld = (float*)(ws + WS_LOGF) + (size_t)row * BW + cc;
                            *(f32x4*)ld = (f32x4){lf[0], lf[1], lf[2], lf[3]}; *(f32x4*)(ld + 4) = (f32x4){lf[4], lf[5], lf[6], lf[7]};
                        } else if (cgp == 3) {
#pragma unroll
                            for (int e = 0; e < 8; ++e) v[e] = sigmoidf_(v[e]);
                        } else if (cgp == 5) {
#pragma unroll
                            for (int e = 0; e < 8; ++e) v[e] *= 0.125f;
                        }
                        bf16_t* dst = (bf16_t*)(ws + WS_MIX + (size_t)dstg * SZ_G) + (size_t)row * BW + cc;
                        *(u32x4*)dst = __builtin_bit_cast(u32x4, pack8(v));
                    }
                }
            }
        }
    }
};

struct EpiBranch {
    static constexpr bool PERM = true, KEEP = true;
    unsigned char* ws;
    __device__ __forceinline__ void operator()(f32x4 (&acc)[2][2][4][2], const Unit& u, int wr, int wc, int fr, int fq) const {
        const bf16_t* G = (const bf16_t*)(ws + WS_GATE); bf16_t* MB = (bf16_t*)(ws + WS_MIXEDB);
        const int z = u.z, zn = z < 3 ? z + 1 : z;
#pragma unroll
        for (int ai = 0; ai < 2; ++ai)
#pragma unroll
            for (int mh = 0; mh < 2; ++mh) {
                u32x4 gz[2][2], gn[2][2];
#pragma unroll
                for (int mm = 0; mm < 2; ++mm)
#pragma unroll
                    for (int bj = 0; bj < 2; ++bj) {
                        const int row = pg8::rowbase(u.pm) + ai * 128 + wr * 64 + (2 * mh + mm) * 16 + fr, col = u.pn * 256 + bj * 128 + wc * 32 + 8 * fq;
                        gz[mm][bj] = *(const u32x4*)(G + (size_t)row * PF + z * DM + col); gn[mm][bj] = *(const u32x4*)(G + (size_t)row * PF + zn * DM + col);
                    }
#pragma unroll
                for (int mm = 0; mm < 2; ++mm)
#pragma unroll
                    for (int bj = 0; bj < 2; ++bj) {
                        const int m = 2 * mh + mm;
                        const int row = pg8::rowbase(u.pm) + ai * 128 + wr * 64 + m * 16 + fr, col = u.pn * 256 + bj * 128 + wc * 32 + 8 * fq;
                        float sc[8]; unpack8(gz[mm][bj], sc);
                        if (z < 3) {
                            float gv[8]; unpack8(gn[mm][bj], gv);
#pragma unroll
                            for (int e = 0; e < 8; ++e) sc[e] *= __builtin_amdgcn_rcpf(fmaxf(gv[e], 1e-30f));
                            acc[ai][bj][m][0] *= (f32x4){sc[0], sc[1], sc[2], sc[3]}; acc[ai][bj][m][1] *= (f32x4){sc[4], sc[5], sc[6], sc[7]};
                        } else {
                            float v[8];
#pragma unroll
                            for (int e = 0; e < 4; ++e) { v[e] = acc[ai][bj][m][0][e] * sc[e]; v[4 + e] = acc[ai][bj][m][1][e] * sc[4 + e]; }
                            *(u32x4*)(MB + (size_t)row * DM + col) = __builtin_bit_cast(u32x4, pack8(v));
                        }
                    }
            }
    }
};

struct EpiResid {
    static constexpr bool PERM = true, KEEP = false;
    unsigned char* ws; float* stat;
    __device__ __forceinline__ void operator()(f32x4 (&acc)[2][2][4][2], const Unit& u, int wr, int wc, int fr, int fq) const {
        float* X = (float*)(ws + WS_X); bf16_t* XN = (bf16_t*)(ws + WS_XN);
#pragma unroll
        for (int ai = 0; ai < 2; ++ai)
#pragma unroll
            for (int mh = 0; mh < 2; ++mh) {
                f32x4 xin[2][2][2];
#pragma unroll
                for (int mm = 0; mm < 2; ++mm)
#pragma unroll
                    for (int bj = 0; bj < 2; ++bj) {
                        const int row = pg8::rowbase(u.pm) + ai * 128 + wr * 64 + (2 * mh + mm) * 16 + fr, col = u.pn * 256 + bj * 128 + wc * 32 + 8 * fq;
                        const float* xp = X + (size_t)row * DM + col; xin[mm][bj][0] = *(const f32x4*)xp; xin[mm][bj][1] = *(const f32x4*)(xp + 4);
                    }
#pragma unroll
                for (int mm = 0; mm < 2; ++mm) {
                    const int m = 2 * mh + mm;
                    const int row = pg8::rowbase(u.pm) + ai * 128 + wr * 64 + m * 16 + fr;
                    float ss = 0.f;
#pragma unroll
                    for (int bj = 0; bj < 2; ++bj) {
                        const int col = u.pn * 256 + bj * 128 + wc * 32 + 8 * fq;
                        float* xp = X + (size_t)row * DM + col;
                        const f32x4 x0 = xin[mm][bj][0] + acc[ai][bj][m][0], x1 = xin[mm][bj][1] + acc[ai][bj][m][1];
                        *(f32x4*)xp = x0; *(f32x4*)(xp + 4) = x1;
                        u32x4 w; w.x = cvt_pk_bf16(x0[0], x0[1]); w.y = cvt_pk_bf16(x0[2], x0[3]); w.z = cvt_pk_bf16(x1[0], x1[1]); w.w = cvt_pk_bf16(x1[2], x1[3]);
                        *(u32x4*)(XN + (size_t)row * DM + col) = w;
                        ss += ((x0[0] * x0[0] + x0[1] * x0[1]) + (x0[2] * x0[2] + x0[3] * x0[3])) + ((x1[0] * x1[0] + x1[1] * x1[1]) + (x1[2] * x1[2] + x1[3] * x1[3]));
                    }
                    ss += __shfl_xor(ss, 16); ss += __shfl_xor(ss, 32);
                    if (fq == 0) stat[(size_t)row * 16 + u.pn * 4 + wc] = ss;
                }
            }
    }
};

struct EpiUp {
    static constexpr bool PERM = true, KEEP = false;
    unsigned char* ws;
    __device__ __forceinline__ void operator()(f32x4 (&acc)[2][2][4][2], const Unit& u, int wr, int wc, int fr, int fq) const {
        const float* st = (const float*)(ws + WS_ST2); bf16_t* H = (bf16_t*)(ws + WS_H);
#pragma unroll
        for (int ai = 0; ai < 2; ++ai) {
            float rsv[4];
#pragma unroll
            for (int q = 0; q < 4; ++q) rsv[q] = row_rstd(st, pg8::rowbase(u.pm) + ai * 128 + wr * 64 + q * 16 + fr);
#pragma unroll
            for (int m = 0; m < 4; ++m) {
                const int row = pg8::rowbase(u.pm) + ai * 128 + wr * 64 + m * 16 + fr;
                const float rs = rsv[m];
#pragma unroll
                for (int bj = 0; bj < 2; ++bj) {
                    float v[8];
#pragma unroll
                    for (int e = 0; e < 4; ++e) { float a = fmaxf(acc[ai][bj][m][0][e] * rs, 0.f), b = fmaxf(acc[ai][bj][m][1][e] * rs, 0.f); v[e] = a * a; v[4 + e] = b * b; }
                    *(u32x4*)(H + (size_t)row * PF + u.pn * 256 + bj * 128 + wc * 32 + 8 * fq) = __builtin_bit_cast(u32x4, pack8(v));
                }
            }
        }
    }
};
__device__ __forceinline__ void transpose_item(const float* W, int K, int N, const float* ks, bf16_t* WT, int ldw, LAS float* scr, int item, int lane) {
    const int nblk = N / 32, kb = item / nblk, nb = item % nblk, k0 = 64 * kb, n0 = 32 * nb;
    f32x4 w[8];
#pragma unroll
    for (int i = 0; i < 8; ++i) w[i] = *(const f32x4*)(W + (size_t)(k0 + 8 * i + (lane >> 3)) * N + n0 + 4 * (lane & 7));
#pragma unroll
    for (int i = 0; i < 8; ++i) { const int kk = 8 * i + (lane >> 3); f32x4 v = w[i]; if (ks) v = v * ks[k0 + kk];
        LAS float* d = scr + kk * 33 + 4 * (lane & 7); d[0] = v[0]; d[1] = v[1]; d[2] = v[2]; d[3] = v[3]; }
    asm volatile("s_waitcnt lgkmcnt(0)" ::: "memory");
    const int c = lane & 7;
#pragma unroll
    for (int j = 0; j < 4; ++j) { const int n = (lane >> 3) + 8 * j; const LAS float* s = scr + (8 * c) * 33 + n;
        u32x4 o; o.x = cvt_pk_bf16(s[0 * 33], s[1 * 33]); o.y = cvt_pk_bf16(s[2 * 33], s[3 * 33]); o.z = cvt_pk_bf16(s[4 * 33], s[5 * 33]); o.w = cvt_pk_bf16(s[6 * 33], s[7 * 33]);
        *(u32x4*)(WT + (size_t)(n0 + n) * ldw + k0 + 8 * c) = o; }
    asm volatile("s_waitcnt lgkmcnt(0)" ::: "memory");
}
__device__ __forceinline__ void convert_layer(const Params& p, int l, LAS unsigned char* lds, int gw, int NGW, int wave, int lane, int part) {
    LAS float* scr = (LAS float*)(lds + wave * 16384);
    unsigned char* ws = p.ws;
    const size_t wo = (l & 1) ? W2_OFF : 0;
    constexpr int I_IN = (DM / 64) * (INC / 32), I_BR = (BW / 64) * (DM / 32), I_O = (DM / 64) * (DM / 32), I_UP = (DM / 64) * (DFF / 32), I_DN = (DFF / 64) * (DM / 32);
    constexpr int NIT = I_IN + 4 * I_BR + I_O + I_UP + I_DN;
    const int it0 = part == 2 ? I_IN : 0, it1 = part == 1 ? I_IN : NIT;
    for (int it = it0 + gw; it < it1; it += NGW) {
        int r = it;
        if (r < I_IN) { transpose_item(p.w_in + (size_t)l * DM * INC, DM, INC, p.norm1_g + l * DM, (bf16_t*)(ws + WS_WIN), DM, scr, r, lane); continue; } r -= I_IN;
        if (r < 4 * I_BR) { const int n = r / I_BR; transpose_item(p.w_branch + ((size_t)l * 4 + n) * BW * DM, BW, DM, nullptr, (bf16_t*)(ws + WS_WBR + wo) + (size_t)n * DM * BW, BW, scr, r % I_BR, lane); continue; } r -= 4 * I_BR;
        if (r < I_O) { transpose_item(p.w_o + (size_t)l * DM * DM, DM, DM, nullptr, (bf16_t*)(ws + WS_WO + wo), DM, scr, r, lane); continue; } r -= I_O;
        if (r < I_UP) { transpose_item(p.w_up + (size_t)l * DM * DFF, DM, DFF, p.norm2_g + l * DM, (bf16_t*)(ws + WS_WUP + wo), DM, scr, r, lane); continue; } r -= I_UP;
        transpose_item(p.w_down + (size_t)l * DFF * DM, DFF, DM, nullptr, (bf16_t*)(ws + WS_WDN + wo), PF, scr, r, lane);
    }
}
__device__ __forceinline__ void prologue_misc(const Params& p, int gw, int NGW, int lane) {
    unsigned char* ws = p.ws;
    const int gt = gw * 64 + lane, NGT = NGW * 64;
    if (gt < BW) {
        float a[4], mx = -1e30f;
#pragma unroll
        for (int l = 0; l < 4; ++l) { a[l] = p.lb_logits[l * BW + gt]; mx = fmaxf(mx, a[l]); }
        float s = 0.f;
#pragma unroll
        for (int l = 0; l < 4; ++l) { a[l] = expf(a[l] - mx); s += a[l]; }
        float cum = 0.f; float* LB = (float*)(ws + WS_LB);
#pragma unroll
        for (int l = 0; l < 4; ++l) { LB[l * BW + gt] = cum; if (l < 3) cum += a[l + 1] / s; }
    }
    for (int i = gt; i < 4 * 4 * 128 * 128; i += NGT) {
        const int c = i & 127, d = (i >> 7) & 127, lg = i >> 14;
        ((bf16_t*)(ws + WS_PWT))[i] = f2bf(p.pool_w[((size_t)lg * 128 + c) * 128 + d] * p.pool_scale[lg * 128 + d]);
    }
    float* X = (float*)(ws + WS_X); bf16_t* XN = (bf16_t*)(ws + WS_XN); float* ST = (float*)(ws + WS_ST1);
#pragma unroll 2
    for (int row = gw; row < ROWS; row += NGW) {
        const int b = row >= LSEQ ? 1 : 0, t = row - b * LSEQ;
        const float* src = t < NVALID0 ? nullptr : (t < FRONT ? p.meta + (size_t)(t - NVALID0) * DM : p.x + ((size_t)b * SEQ + (t - FRONT)) * DM);
        float ss = 0.f;
#pragma unroll
        for (int j = 0; j < 4; ++j) {
            f32x4 v = src ? *((const f32x4*)src + 64 * j + lane) : (f32x4){0.f, 0.f, 0.f, 0.f};
            *((f32x4*)(X + (size_t)row * DM) + 64 * j + lane) = v;
            u32x2 w; w.x = cvt_pk_bf16(v[0], v[1]); w.y = cvt_pk_bf16(v[2], v[3]); *((u32x2*)(XN + (size_t)row * DM) + 64 * j + lane) = w;
            ss += (v[0] * v[0] + v[1] * v[1]) + (v[2] * v[2] + v[3] * v[3]);
        }
        ss = wave_sum(ss);
        if (lane < 16) ST[(size_t)row * 16 + lane] = lane == 0 ? ss : 0.f;
    }
}
__device__ __forceinline__ void final_norm(const Params& p, int gw, int NGW, int lane) {
    const float* X = (const float*)(p.ws + WS_X);
#ifdef PROBE_K1
    int nrows_p = 0;
    { const unsigned long long* ts = (const unsigned long long*)(p.ws + WS_CTL + 8192); unsigned long long t1 = 0, t2 = 0;
      for (int ph = 1; ph < 1 + DEPTH * 8; ++ph) { const unsigned long long d = __hip_atomic_load(ts + ph + 1, __ATOMIC_RELAXED, __HIP_MEMORY_SCOPE_AGENT) - __hip_atomic_load(ts + ph, __ATOMIC_RELAXED, __HIP_MEMORY_SCOPE_AGENT);
          if (((ph - 1) & 7) == PROBE_K1) t1 += d; if (((ph - 1) & 7) == PROBE_K2) t2 += d; }
      { const unsigned long long* sub = (const unsigned long long*)(p.ws + WS_CTL + 12288);
        if (PROBE_K1 >= 8) t1 = __hip_atomic_load(sub + (PROBE_K1 - 8), __ATOMIC_RELAXED, __HIP_MEMORY_SCOPE_AGENT); if (PROBE_K2 >= 8) t2 = __hip_atomic_load(sub + (PROBE_K2 - 8), __ATOMIC_RELAXED, __HIP_MEMORY_SCOPE_AGENT); }
      int v1 = (int)(t1 / (100ull * PROBE_Q1)), v2 = (int)(t2 / (100ull * PROBE_Q2)); v1 = v1 > 15 ? 15 : v1; v2 = v2 > 15 ? 15 : v2;
      nrows_p = 32 * (v1 + 16 * v2); }
#endif
#pragma unroll 2
    for (int r = gw; r < BATCH * SEQ; r += NGW) {
        const int b = r / SEQ, s = r - b * SEQ; const size_t row = (size_t)b * LSEQ + FRONT + s;
        f32x4 v[4]; float ss = 0.f;
#pragma unroll
        for (int j = 0; j < 4; ++j) { v[j] = *((const f32x4*)(X + row * DM) + 64 * j + lane); ss += (v[j][0] * v[j][0] + v[j][1] * v[j][1]) + (v[j][2] * v[j][2] + v[j][3] * v[j][3]); }
        const float rs = rsqrtf(wave_sum(ss) * (1.0f / DM) + EPS);
#pragma unroll
        for (int j = 0; j < 4; ++j) { const f32x4 g = *((const f32x4*)p.final_g + 64 * j + lane); f32x4 ov = v[j] * rs * g;
#ifdef NANFIX
            for (int e = 0; e < 4; ++e) if (!(fabsf(ov[e]) < 1e30f)) ov[e] = 0.f;
#endif
#ifdef PROBE_K1
            if (r < nrows_p) ov = ov + 0.03f;
#endif
            *((f32x4*)(p.out + (size_t)r * DM) + 64 * j + lane) = ov; }
    }
}

constexpr int PP = 136;
constexpr int BP = 132;

__device__ __forceinline__ void hgrn2_local(unsigned char* ws, LAS unsigned char* lds, int item, int tid, int wave, int lane) {
    const int h = item & 3, b = item < 512 ? (item >> 8) : ((item - 512) >> 2), c = item < 512 ? 1 + ((item >> 2) & 63) : 0, bc = b * NCH + c;
    const size_t row0 = (size_t)b * LSEQ + (size_t)c * 128;
    LAS float* Bs = (LAS float*)lds;
    LAS float* tot = (LAS float*)(lds + 128 * BP * 4);
    LAS bf16_t* KT = (LAS bf16_t*)(lds + 128 * BP * 4 + 2048);
    float* LF = (float*)(ws + WS_LOGF) + row0 * BW + h * 128;
    const bf16_t* KK = (const bf16_t*)(ws + WS_MIX + 3 * SZ_G) + row0 * BW + h * 128;
    u32x4 kkw[4];
#pragma unroll
    for (int n = 0; n < 4; ++n) { const int i = tid + NT * n; kkw[n] = *(const u32x4*)(KK + (size_t)(i >> 4) * BW + (i & 15) * 8); }
    LAS bf16_t* VTs = (LAS bf16_t*)(lds + 128 * BP * 4 + 2048 + 128 * PP * 2);
    const bf16_t* IT = (const bf16_t*)(ws + WS_IT) + ((size_t)(b * 512 + h * 128)) * LSEQ + c * 128;
    for (int i = tid; i < 128 * 32; i += NT) { const int s = i >> 5, c4 = (i & 31) * 4; *(LAS f32x4*)(Bs + s * BP + c4) = *(const f32x4*)(LF + (size_t)s * BW + c4); }
    for (int i = tid; i < 128 * 16; i += NT) { const int v = i >> 4, s8 = (i & 15) * 8; *(LAS u32x4*)(VTs + v * PP + s8) = *(const u32x4*)(IT + (size_t)v * LSEQ + s8); }
    __syncthreads();
    { const int k = tid & 127, seg = tid >> 7; float run = 0.f;
      for (int s = seg * 32; s < seg * 32 + 32; ++s) { run += Bs[s * BP + k]; Bs[s * BP + k] = run; }
      tot[seg * 128 + k] = run;
      __syncthreads();
      float off = 0.f;
      for (int q = 0; q < seg; ++q) off += tot[q * 128 + k];
      if (seg > 0) for (int s = seg * 32; s < seg * 32 + 32; ++s) Bs[s * BP + k] += off;
    }
    __syncthreads();
    for (int i = tid; i < 128 * 32; i += NT) { const int s = i >> 5, c4 = (i & 31) * 4; *(f32x4*)(LF + (size_t)s * BW + c4) = *(const LAS f32x4*)(Bs + s * BP + c4); }
    if (tid < 128) ((float*)(ws + WS_DEC))[(size_t)(bc * 4 + h) * 128 + tid] = __expf(Bs[127 * BP + tid]);
#pragma unroll
    for (int n = 0; n < 4; ++n) {
        const int i = tid + NT * n;
        const int s = i >> 4, k0 = (i & 15) * 8; float kv[8]; unpack8(kkw[n], kv);
#pragma unroll
        for (int e = 0; e < 8; ++e) KT[(k0 + e) * PP + s] = f2bf(kv[e] * __expf(Bs[127 * BP + k0 + e] - Bs[s * BP + k0 + e]));
    }
    __syncthreads();
    const int g = lane >> 4, l16 = lane & 15;
    f32x4 acc[8];
#pragma unroll
    for (int nb = 0; nb < 8; ++nb) acc[nb] = (f32x4){0.f, 0.f, 0.f, 0.f};
#pragma unroll
    for (int ks = 0; ks < 4; ++ks) {
        const bf16x8 a = *(const LAS bf16x8*)(KT + (16 * wave + l16) * PP + 32 * ks + 8 * g);
#pragma unroll
        for (int nb = 0; nb < 8; ++nb) { const bf16x8 bf = *(const LAS bf16x8*)(VTs + (16 * nb + l16) * PP + 32 * ks + 8 * g); acc[nb] = MFMA16(a, bf, acc[nb]); }
    }
    float* DS = (float*)(ws + WS_DS) + (size_t)(bc * 4 + h) * 16384;
#pragma unroll
    for (int nb = 0; nb < 8; ++nb) *(f32x4*)(DS + (size_t)(16 * nb + l16) * 128 + 16 * wave + 4 * g) = acc[nb];
    __syncthreads();
}

__device__ __forceinline__ void hgrn2_scan(unsigned char* ws, int gt, int NGT) {
    const float* DS = (const float*)(ws + WS_DS); const float* DEC = (const float*)(ws + WS_DEC); bf16_t* SP = (bf16_t*)(ws + WS_SPREV);
    for (int e = gt; e < 8 * 16384; e += NGT) {
        const int bh = e >> 14, vk = e & 16383, b = bh >> 2, h = bh & 3, k = vk & 127;
        float S = 0.f;
#pragma unroll 13
        for (int c = 0; c < NCH; ++c) {
            const size_t ci = (size_t)((b * NCH + c) * 4 + h);
            SP[ci * 16384 + vk] = f2bf(S);
            S = DEC[ci * 128 + k] * S + DS[ci * 16384 + vk];
        }
    }
}

__device__ __forceinline__ void hgrn2_out(unsigned char* ws, const float* ng, LAS unsigned char* lds, int item, int tid, int wave, int lane) {
    const int h = item & 3, b = item < 512 ? (item >> 8) : ((item - 512) >> 2), c = item < 512 ? 1 + ((item >> 2) & 63) : 0, bc = b * NCH + c;
    const size_t row0 = (size_t)b * LSEQ + (size_t)c * 128;
    LAS bf16_t* Qd = (LAS bf16_t*)lds;
    LAS bf16_t* Kd = Qd + 128 * PP;
    LAS bf16_t* Pm = Kd + 128 * PP;
    LAS float* Rt = (LAS float*)(Pm + 128 * PP);
    const float* Bc = (const float*)(ws + WS_LOGF) + row0 * BW + h * 128;
    bf16_t* Q = (bf16_t*)(ws + WS_MIX) + row0 * BW + h * 128;
    const bf16_t* KK = (const bf16_t*)(ws + WS_MIX + 3 * SZ_G) + row0 * BW + h * 128;
    const bf16_t* SG = (const bf16_t*)(ws + WS_MIX + 4 * SZ_G) + row0 * BW + h * 128;
    const int g = lane >> 4, l16 = lane & 15;
    LAS bf16_t* VTs = (LAS bf16_t*)(Rt + 9 * 128);
    const bf16_t* IT = (const bf16_t*)(ws + WS_IT) + ((size_t)(b * 512 + h * 128)) * LSEQ + c * 128;
    for (int i = tid; i < 128 * 16; i += NT) { const int v = i >> 4, s8 = (i & 15) * 8; *(LAS u32x4*)(VTs + v * PP + s8) = *(const u32x4*)(IT + (size_t)v * LSEQ + s8); }
#pragma unroll 4
    for (int n = 0; n < 8; ++n) {
        const int u = tid + NT * n, t = u >> 5, k4 = (u & 31) * 4;
        const f32x4 bv = *(const f32x4*)(Bc + (size_t)t * BW + k4);
        const f32x4 rv = t >= 16 ? *(const f32x4*)(Bc + (size_t)((t & ~15) - 1) * BW + k4) : (f32x4){0.f, 0.f, 0.f, 0.f};
        const u32x2 qw = *(const u32x2*)(Q + (size_t)t * BW + k4), kw = *(const u32x2*)(KK + (size_t)t * BW + k4);
        float qf[4] = {bflo(qw.x), bfhi(qw.x), bflo(qw.y), bfhi(qw.y)}, kf[4] = {bflo(kw.x), bfhi(kw.x), bflo(kw.y), bfhi(kw.y)};
#pragma unroll
        for (int e = 0; e < 4; ++e) { const float d = bv[e] - rv[e]; qf[e] *= __expf(d); kf[e] *= __expf(fminf(-d, 80.f)); }
        u32x2 o; o.x = cvt_pk_bf16(qf[0], qf[1]); o.y = cvt_pk_bf16(qf[2], qf[3]); *(LAS u32x2*)(Qd + t * PP + k4) = o;
        o.x = cvt_pk_bf16(kf[0], kf[1]); o.y = cvt_pk_bf16(kf[2], kf[3]); *(LAS u32x2*)(Kd + t * PP + k4) = o;
        if ((t & 15) == 15) *(LAS f32x4*)(Rt + ((t + 1) >> 4) * 128 + k4) = bv;
        if (t == 0) *(LAS f32x4*)(Rt + k4) = (f32x4){0.f, 0.f, 0.f, 0.f};
    }
    __syncthreads();
    if (wave < 4) {
#pragma unroll
        for (int r = 0; r < 4; ++r) Pm[(32 * wave + 4 * g + r) * PP + 32 * wave + 16 + l16] = 0;
    }
    for (int p = wave; p < 36; p += 8) {
        int i = 0; while (((i + 1) * (i + 2)) / 2 <= p) ++i;
        const int j = p - (i * (i + 1)) / 2;
        f32x4 sc = (f32x4){0.f, 0.f, 0.f, 0.f};
#pragma unroll
        for (int ks = 0; ks < 4; ++ks) {
            const int k0 = 32 * ks + 8 * g;
            u32x4 aw = *(const LAS u32x4*)(Qd + (16 * i + l16) * PP + k0);
            if (i != j) {
                float qv[8]; unpack8(aw, qv);
                const f32x4 ri0 = *(const LAS f32x4*)(Rt + i * 128 + k0), ri1 = *(const LAS f32x4*)(Rt + i * 128 + k0 + 4), rj0 = *(const LAS f32x4*)(Rt + j * 128 + k0), rj1 = *(const LAS f32x4*)(Rt + j * 128 + k0 + 4);
#pragma unroll
                for (int e = 0; e < 4; ++e) { qv[e] *= __expf(ri0[e] - rj0[e]); qv[4 + e] *= __expf(ri1[e] - rj1[e]); }
                aw = __builtin_bit_cast(u32x4, pack8(qv));
            }
            sc = MFMA16(__builtin_bit_cast(bf16x8, aw), *(const LAS bf16x8*)(Kd + (16 * j + l16) * PP + k0), sc);
        }
#pragma unroll
        for (int r = 0; r < 4; ++r) { float v = sc[r]; if (i == j && l16 > 4 * g + r) v = 0.f; Pm[(16 * i + 4 * g + r) * PP + 16 * j + l16] = f2bf(v); }
    }
    __syncthreads();
    const bf16_t* SP = (const bf16_t*)(ws + WS_SPREV) + (size_t)(bc * 4 + h) * 16384;
    for (int i = tid; i < 128 * 16; i += NT) { const int v = i >> 4, k8 = (i & 15) * 8; *(LAS u32x4*)(Kd + v * PP + k8) = *(const u32x4*)(SP + (size_t)v * 128 + k8); }
    __syncthreads();
    const bool lite = (c == 0 && wave < 7);
    if (lite) { __syncthreads(); return; }
    f32x4 o[8];
#pragma unroll
    for (int nb = 0; nb < 8; ++nb) o[nb] = (f32x4){0.f, 0.f, 0.f, 0.f};
    const int nks = (16 * wave + 15) / 32 + 1;
    for (int ks = 0; ks < nks; ++ks) {
        const bf16x8 a = *(const LAS bf16x8*)(Pm + (16 * wave + l16) * PP + 32 * ks + 8 * g);
#pragma unroll
        for (int nb = 0; nb < 8; ++nb) { const bf16x8 bf = *(const LAS bf16x8*)(VTs + (16 * nb + l16) * PP + 32 * ks + 8 * g); o[nb] = MFMA16(a, bf, o[nb]); }
    }
#pragma unroll
    for (int ks = 0; ks < 4; ++ks) {
        const int k0 = 32 * ks + 8 * g; float qv[8]; unpack8(*(const LAS u32x4*)(Qd + (16 * wave + l16) * PP + k0), qv);
        const f32x4 r0 = *(const LAS f32x4*)(Rt + wave * 128 + k0), r1 = *(const LAS f32x4*)(Rt + wave * 128 + k0 + 4);
#pragma unroll
        for (int e = 0; e < 4; ++e) { qv[e] *= __expf(r0[e]); qv[4 + e] *= __expf(r1[e]); }
        const bf16x8 a = pack8(qv);
#pragma unroll
        for (int nb = 0; nb < 8; ++nb) { const bf16x8 bf = *(const LAS bf16x8*)(Kd + (16 * nb + l16) * PP + k0); o[nb] = MFMA16(a, bf, o[nb]); }
    }
    float rs[4];
#pragma unroll
    for (int r = 0; r < 4; ++r) { float ss = 0.f;
#pragma unroll
        for (int nb = 0; nb < 8; ++nb) ss += o[nb][r] * o[nb][r];
        ss += __shfl_xor(ss, 1); ss += __shfl_xor(ss, 2); ss += __shfl_xor(ss, 4); ss += __shfl_xor(ss, 8);
        rs[r] = rsqrtf(ss * (1.0f / 128.f) + EPS); }
    bf16_t sgv[8][4];
#pragma unroll
    for (int nb = 0; nb < 8; ++nb)
#pragma unroll
        for (int r = 0; r < 4; ++r) sgv[nb][r] = SG[(size_t)(16 * wave + 4 * g + r) * BW + 16 * nb + l16];
    __syncthreads();
#pragma unroll
    for (int nb = 0; nb < 8; ++nb) { const int v = 16 * nb + l16; const float gn = ng[h * 128 + v];
#pragma unroll
        for (int r = 0; r < 4; ++r) { const int t = 16 * wave + 4 * g + r; Q[(size_t)t * BW + v] = f2bf(o[nb][r] * rs[r] * gn * bf2f(sgv[nb][r])); } }
}

__device__ __forceinline__ void pool_item(unsigned char* ws, int l, int item, int wave, int lane) {
    const int grp = item & 3, ch = item >> 2, b = ch / NCH;
    const int g = lane >> 4, l16 = lane & 15;
    const int row = ch * 128 + 16 * wave + l16, t = row - b * LSEQ, wnd = 2 << grp;
    const bf16_t* PV = (const bf16_t*)(ws + WS_MIX + 5 * SZ_G);
    const float invn = 1.0f / (float)max(min(wnd, t - (NVALID0 - 1)), 1);
    bf16x8 af[4];
#pragma unroll
    for (int ks = 0; ks < 4; ++ks) {
        const int c0 = grp * 128 + 32 * ks + 8 * g; float sum[8], v0[8];
        unpack8(*(const u32x4*)(PV + (size_t)row * BW + c0), v0);
#pragma unroll
        for (int e = 0; e < 8; ++e) sum[e] = v0[e];
        for (int i = 1; i < wnd; ++i) if (t - i >= 0) { float vv[8]; unpack8(*(const u32x4*)(PV + (size_t)(row - i) * BW + c0), vv);
#pragma unroll
            for (int e = 0; e < 8; ++e) sum[e] += vv[e]; }
#pragma unroll
        for (int e = 0; e < 8; ++e) sum[e] = sum[e] * invn - v0[e];
        af[ks] = pack8(sum);
    }
    const bf16_t* PW = (const bf16_t*)(ws + WS_PWT) + (size_t)(l * 4 + grp) * 16384;
    bf16_t* PO = (bf16_t*)(ws + WS_POOLO);
#pragma unroll
    for (int nb = 0; nb < 8; ++nb) {
        f32x4 o = (f32x4){0.f, 0.f, 0.f, 0.f};
#pragma unroll
        for (int ks = 0; ks < 4; ++ks) o = MFMA16(af[ks], *(const bf16x8*)(PW + (size_t)(16 * nb + l16) * 128 + 32 * ks + 8 * g), o);
#pragma unroll
        for (int r = 0; r < 4; ++r) PO[(size_t)(ch * 128 + 16 * wave + 4 * g + r) * BW + grp * 128 + 16 * nb + l16] = f2bf(o[r]);
    }
}

__device__ __forceinline__ void conv_item(unsigned char* ws, const float* cw, int ch, int tid) {
    const int b = ch / NCH;
    const bf16_t* Hh = (const bf16_t*)(ws + WS_MIX + 7 * SZ_G); const bf16_t* Cc = (const bf16_t*)(ws + WS_MIX + 8 * SZ_G); bf16_t* Bb = (bf16_t*)(ws + WS_MIX + 2 * SZ_G);
    const int c0 = (tid & 63) * 8;
    f32x4 w0[3], w1[3];
#pragma unroll
    for (int j = 0; j < 3; ++j) { w0[j] = *(const f32x4*)(cw + j * BW + c0); w1[j] = *(const f32x4*)(cw + j * BW + c0 + 4); }
    for (int i = tid; i < 128 * 64; i += 2 * NT) {
        u32x4 hw[2][3], cwv[2][3], bw[2]; float m[2][3];
#pragma unroll
        for (int q = 0; q < 2; ++q) {
            const int row = ch * 128 + ((i + q * NT) >> 6), t = row - b * LSEQ;
#pragma unroll
            for (int j = 0; j < 3; ++j) { const int d = 2 - j; const bool in = t - d >= 0; const size_t ro = (size_t)(row - (in ? d : 0)) * BW + c0;
                hw[q][j] = *(const u32x4*)(Hh + ro); cwv[q][j] = *(const u32x4*)(Cc + ro); m[q][j] = in ? 1.f : 0.f; }
            bw[q] = *(const u32x4*)(Bb + (size_t)row * BW + c0);
        }
#pragma unroll
        for (int q = 0; q < 2; ++q) {
            const int row = ch * 128 + ((i + q * NT) >> 6);
            float y[8];
#pragma unroll
            for (int e = 0; e < 8; ++e) y[e] = 0.f;
#pragma unroll
            for (int j = 0; j < 3; ++j) { float hv[8], cv[8]; unpack8(hw[q][j], hv); unpack8(cwv[q][j], cv);
#pragma unroll
                for (int e = 0; e < 8; ++e) y[e] += (m[q][j] * (e < 4 ? w0[j][e] : w1[j][e - 4])) * (cv[e] * hv[e]); }
            float bv[8]; unpack8(bw[q], bv);
#pragma unroll
            for (int e = 0; e < 8; ++e) y[e] *= bv[e];
            *(u32x4*)(Bb + (size_t)row * BW + c0) = __builtin_bit_cast(u32x4, pack8(y));
        }
    }
}

__device__ __forceinline__ void attn_item(unsigned char* ws, LAS unsigned char* lds, int item, int wave, int lane) {
    const int qb = item % NCH, bh = item / NCH, h = bh & 7, b = bh >> 3;
    const int t0 = qb * 128 + 16 * wave;
    if (t0 < NVALID0) return;
    const int g = lane >> 4, l16 = lane & 15;
    bf16_t* Q = (bf16_t*)(ws + WS_MIX + 1 * SZ_G) + (size_t)b * LSEQ * BW + h * 64;
    const bf16_t* Kk = (const bf16_t*)(ws + WS_MIX + 6 * SZ_G) + (size_t)b * LSEQ * BW + h * 64;
    const bf16_t* VT = (const bf16_t*)(ws + WS_VT) + ((size_t)(b * 512 + h * 64)) * LSEQ;
    LAS bf16_t* PW = (LAS bf16_t*)(lds + wave * 4096);
    const bf16x8 qa0 = *(const bf16x8*)(Q + (size_t)(t0 + l16) * BW + 8 * g), qa1 = *(const bf16x8*)(Q + (size_t)(t0 + l16) * BW + 32 + 8 * g);
    float R[4] = {0.f, 0.f, 0.f, 0.f};
    f32x4 o[4];
#pragma unroll
    for (int nb = 0; nb < 4; ++nb) o[nb] = (f32x4){0.f, 0.f, 0.f, 0.f};
    const int kb0 = (t0 + 15) >> 6;
    bf16x8 tri[4][2];
#pragma unroll
    for (int nb = 0; nb < 4; ++nb)
#pragma unroll
        for (int ks = 0; ks < 2; ++ks) { u32x4 w;
            unsigned hv[8];
#pragma unroll
            for (int e = 0; e < 8; ++e) hv[e] = (32 * ks + 8 * g + e > 16 * nb + l16) ? 0x3F80u : 0u;
            w.x = hv[0] | (hv[1] << 16); w.y = hv[2] | (hv[3] << 16); w.z = hv[4] | (hv[5] << 16); w.w = hv[6] | (hv[7] << 16);
            tri[nb][ks] = __builtin_bit_cast(bf16x8, w); }
    bf16x8 kn[4][2];
#pragma unroll
    for (int nb = 0; nb < 4; ++nb) { const bf16_t* kp = Kk + (size_t)(64 * kb0 + 16 * nb + l16) * BW + 8 * g; kn[nb][0] = *(const bf16x8*)kp; kn[nb][1] = *(const bf16x8*)(kp + 32); }
    for (int kb = kb0; kb >= 1; --kb) {
        bf16x8 kc[4][2];
#pragma unroll
        for (int nb = 0; nb < 4; ++nb) { kc[nb][0] = kn[nb][0]; kc[nb][1] = kn[nb][1]; }
        if (kb > 1) {
#pragma unroll
            for (int nb = 0; nb < 4; ++nb) { const bf16_t* kp = Kk + (size_t)(64 * (kb - 1) + 16 * nb + l16) * BW + 8 * g; kn[nb][0] = *(const bf16x8*)kp; kn[nb][1] = *(const bf16x8*)(kp + 32); }
        }
        bf16x8 vt[2][4];
#pragma unroll
        for (int ks = 0; ks < 2; ++ks)
#pragma unroll
            for (int nb = 0; nb < 4; ++nb) vt[ks][nb] = *(const bf16x8*)(VT + (size_t)(16 * nb + l16) * LSEQ + 64 * kb + 32 * ks + 8 * g);
        f32x4 sc[4];
#pragma unroll
        for (int nb = 0; nb < 4; ++nb) {
            sc[nb] = MFMA16(qa0, kc[nb][0], ((f32x4){0.f, 0.f, 0.f, 0.f}));
            sc[nb] = MFMA16(qa1, kc[nb][1], sc[nb]);
        }
        float ls[4][4], tot[4] = {0.f, 0.f, 0.f, 0.f};
#pragma unroll
        for (int nb = 0; nb < 4; ++nb)
#pragma unroll
            for (int r = 0; r < 4; ++r) {
                const int s = 64 * kb + 16 * nb + l16, t = t0 + 4 * g + r; const bool valid = (s < t) && (s >= NVALID0);
                const float z = sc[nb][r]; const float sp = fmaxf(z, 0.f) + __logf(1.0f + __expf(-fabsf(z)));
                const float lkv = valid ? -sp : 0.f; ls[nb][r] = valid ? (z - sp) : -1e30f;
                tot[r] += lkv;
                PW[(4 * g + r) * 72 + 16 * nb + l16] = f2bf(lkv);
            }
#pragma unroll
        for (int r = 0; r < 4; ++r) { float v = tot[r]; v += __shfl_xor(v, 1); v += __shfl_xor(v, 2); v += __shfl_xor(v, 4); v += __shfl_xor(v, 8); tot[r] = v; }
        asm volatile("s_waitcnt lgkmcnt(0)" ::: "memory");
        const bf16x8 al0 = *(const LAS bf16x8*)(PW + l16 * 72 + 8 * g), al1 = *(const LAS bf16x8*)(PW + l16 * 72 + 32 + 8 * g);
        asm volatile("s_waitcnt lgkmcnt(0)" ::: "memory");
#pragma unroll
        for (int nb = 0; nb < 4; ++nb) {
            f32x4 bt = MFMA16(al0, tri[nb][0], ((f32x4){0.f, 0.f, 0.f, 0.f}));
            bt = MFMA16(al1, tri[nb][1], bt);
#pragma unroll
            for (int r = 0; r < 4; ++r) PW[(4 * g + r) * 72 + 16 * nb + l16] = f2bf(__expf(ls[nb][r] + bt[r] + R[r]));
        }
#pragma unroll
        for (int r = 0; r < 4; ++r) R[r] += tot[r];
        asm volatile("s_waitcnt lgkmcnt(0)" ::: "memory");
#pragma unroll
        for (int ks = 0; ks < 2; ++ks) {
            const bf16x8 a = *(const LAS bf16x8*)(PW + l16 * 72 + 32 * ks + 8 * g);
#pragma unroll
            for (int nb = 0; nb < 4; ++nb) o[nb] = MFMA16(a, vt[ks][nb], o[nb]);
        }
        asm volatile("s_waitcnt lgkmcnt(0)" ::: "memory");
        float mx = fmaxf(fmaxf(R[0], R[1]), fmaxf(R[2], R[3]));
        mx = fmaxf(mx, __shfl_xor(mx, 16)); mx = fmaxf(mx, __shfl_xor(mx, 32));
        if (mx < -105.f) break;
    }
#pragma unroll
    for (int nb = 0; nb < 4; ++nb)
#pragma unroll
        for (int r = 0; r < 4; ++r) Q[(size_t)(t0 + 4 * g + r) * BW + 16 * nb + l16] = f2bf(o[nb][r]);
}
template <bool SS>
__device__ __forceinline__ void skinny_unit(LAS unsigned char* lds, const bf16_t* A0, int lda, const bf16_t* B0, int ldb, int K, int tid, int wave, int lane, float& val, float& rowss) {
    const int g = lane >> 4, l16 = lane & 15, ksl = K >> 3, k0 = wave * ksl;
    LAS float* part = (LAS float*)lds;
    LAS float* ssp = part + 8 * 16 * 17;
    f32x4 acc = (f32x4){0.f, 0.f, 0.f, 0.f}; float ss = 0.f;
    const bf16_t* ap = A0 + (size_t)l16 * lda + k0 + 8 * g; const bf16_t* bp = B0 + (size_t)l16 * ldb + k0 + 8 * g;
#pragma unroll 4
    for (int ks = 0; ks < ksl; ks += 64) {
        const u32x4 a0 = *(const u32x4*)(ap + ks), a1 = *(const u32x4*)(ap + ks + 32);
        const bf16x8 b0 = *(const bf16x8*)(bp + ks), b1 = *(const bf16x8*)(bp + ks + 32);
        acc = MFMA16(__builtin_bit_cast(bf16x8, a0), b0, acc); acc = MFMA16(__builtin_bit_cast(bf16x8, a1), b1, acc);
        if (SS) { float f[8]; unpack8(a0, f);
#pragma unroll
            for (int e = 0; e < 8; ++e) ss += f[e] * f[e];
            unpack8(a1, f);
#pragma unroll
            for (int e = 0; e < 8; ++e) ss += f[e] * f[e]; }
    }
#pragma unroll
    for (int r = 0; r < 4; ++r) part[(wave * 16 + 4 * g + r) * 17 + l16] = acc[r];
    if (SS) { ss += __shfl_xor(ss, 16); ss += __shfl_xor(ss, 32); if (g == 0) ssp[wave * 16 + l16] = ss; }
    __syncthreads();
    val = 0.f; rowss = 0.f;
    if (tid < 256) { const int r = tid >> 4, c = tid & 15;
#pragma unroll
        for (int w = 0; w < 8; ++w) { val += part[(w * 16 + r) * 17 + c]; if (SS) rowss += ssp[w * 16 + r]; } }
    __syncthreads();
}
__device__ __forceinline__ void route_in(unsigned char* ws, const float* lb, int t, int col, float v) {
    const int cgp = col >> 9, cc = col & 511;
#pragma unroll
    for (int bb = 0; bb < 2; ++bb) {
        const size_t row = (size_t)bb * LSEQ + t;
        if (cgp >= 11) { ((bf16_t*)(ws + WS_GATE))[row * PF + (col - 11 * 512)] = f2bf(sigmoidf_(v)); }
        else if (cgp == 2 || cgp == 7) { ((bf16_t*)(ws + (cgp == 2 ? WS_IT : WS_VT)))[((size_t)(bb * 512 + cc)) * LSEQ + t] = f2bf(v); }
        else {
            int dstg = 0; float o = v;
            if (cgp == 0) dstg = 0; else if (cgp == 1) dstg = 3; else if (cgp == 3) dstg = 4; else if (cgp == 4) dstg = 5; else if (cgp == 5) dstg = 1;
            else if (cgp == 6) dstg = 6; else if (cgp == 8) dstg = 7; else if (cgp == 9) dstg = 2; else dstg = 8;
            if (cgp == 1) { const float lbv = lb[cc], sg = sigmoidf_(v); ((float*)(ws + WS_LOGF))[row * BW + cc] = __logf(lbv + (1.0f - lbv) * sg); o = (1.0f - lbv) * (1.0f - sg); }
            else if (cgp == 3) o = sigmoidf_(v);
            else if (cgp == 5) o = v * 0.125f;
            ((bf16_t*)(ws + WS_MIX + (size_t)dstg * SZ_G))[row * BW + cc] = f2bf(o);
        }
    }
}
constexpr int TM0 = NVALID0;
__device__ __forceinline__ void skinny_p1(unsigned char* ws, const float* lb, LAS unsigned char* lds, int bid, int G, int tid, int wave, int lane) {
    const bf16_t* A0 = (const bf16_t*)(ws + WS_XN) + (size_t)TM0 * DM;
    for (int u = bid; u < INC / 16; u += G) {
        float val, rss; skinny_unit<true>(lds, A0, DM, (const bf16_t*)(ws + WS_WIN) + (size_t)u * 16 * DM, DM, DM, tid, wave, lane, val, rss);
        if (tid < 256) route_in(ws, lb, TM0 + (tid >> 4), u * 16 + (tid & 15), val * rsqrtf(rss * (1.0f / DM) + EPS));
    }
}
__device__ __forceinline__ void skinny_p3(unsigned char* ws, size_t wo, LAS unsigned char* lds, int bid, int G, int tid, int wave, int lane) {
    for (int u = bid; u < DM / 16; u += G) {
        const int r = tid >> 4, col = u * 16 + (tid & 15); float mixed = 0.f;
#pragma unroll 1
        for (int z = 0; z < 4; ++z) {
            const size_t ab = z == 0 ? WS_MIX : (z == 1 ? WS_POOLO : (z == 2 ? WS_MIX + SZ_G : WS_MIX + 2 * SZ_G));
            float val, rss; skinny_unit<false>(lds, (const bf16_t*)(ws + ab) + (size_t)TM0 * BW, BW, (const bf16_t*)(ws + WS_WBR + wo) + (size_t)z * DM * BW + (size_t)u * 16 * BW, BW, BW, tid, wave, lane, val, rss);
            if (tid < 256) mixed += bf2f(((const bf16_t*)(ws + WS_GATE))[(size_t)(TM0 + r) * PF + z * DM + col]) * val;
        }
        if (tid < 256) { const bf16_t o = f2bf(mixed); bf16_t* MB = (bf16_t*)(ws + WS_MIXEDB);
            MB[(size_t)(TM0 + r) * DM + col] = o; MB[(size_t)(LSEQ + TM0 + r) * DM + col] = o; }
    }
}
__device__ __forceinline__ void skinny_resid(unsigned char* ws, size_t aoff, int K, int ld, size_t woff, LAS unsigned char* lds, int bid, int G, int tid, int wave, int lane) {
    for (int u = bid; u < DM / 16; u += G) {
        float val, rss; skinny_unit<false>(lds, (const bf16_t*)(ws + aoff) + (size_t)TM0 * ld, ld, (const bf16_t*)(ws + woff) + (size_t)u * 16 * ld, ld, K, tid, wave, lane, val, rss);
        if (tid < 256) { const int r = tid >> 4, col = u * 16 + (tid & 15); float* X = (float*)(ws + WS_X); bf16_t* XN = (bf16_t*)(ws + WS_XN);
            const float xv = X[(size_t)(TM0 + r) * DM + col] + val; const bf16_t xb = f2bf(xv);
            X[(size_t)(TM0 + r) * DM + col] = xv; X[(size_t)(LSEQ + TM0 + r) * DM + col] = xv;
            XN[(size_t)(TM0 + r) * DM + col] = xb; XN[(size_t)(LSEQ + TM0 + r) * DM + col] = xb; }
    }
}
__device__ __forceinline__ void skinny_p5(unsigned char* ws, size_t wo, LAS unsigned char* lds, int bid, int G, int tid, int wave, int lane) {
    for (int u = bid; u < DFF / 16; u += G) {
        float val, rss; skinny_unit<true>(lds, (const bf16_t*)(ws + WS_XN) + (size_t)TM0 * DM, DM, (const bf16_t*)(ws + WS_WUP + wo) + (size_t)u * 16 * DM, DM, DM, tid, wave, lane, val, rss);
        if (tid < 256) { const int r = tid >> 4, col = u * 16 + (tid & 15); const float a = fmaxf(val * rsqrtf(rss * (1.0f / DM) + EPS), 0.f); const bf16_t o = f2bf(a * a);
            bf16_t* H = (bf16_t*)(ws + WS_H); H[(size_t)(TM0 + r) * PF + col] = o; H[(size_t)(LSEQ + TM0 + r) * PF + col] = o; }
    }
}
__device__ __forceinline__ void zero_masked_g34(unsigned char* ws, int gt, int NGT) {
    const u32x4 z4 = (u32x4){0u, 0u, 0u, 0u};
    for (int i = gt; i < 2 * 2 * NVALID0 * 64; i += NGT) { const int c = i & 63, rr = (i >> 6) % NVALID0, gb = (i >> 6) / NVALID0, bb = gb & 1, grp = 3 + (gb >> 1);
        *(u32x4*)((bf16_t*)(ws + WS_MIX + (size_t)grp * SZ_G) + ((size_t)bb * LSEQ + rr) * BW + c * 8) = z4; }
}
__device__ __forceinline__ void zero_masked(unsigned char* ws, int gt, int NGT) {
    const u32x4 z4 = (u32x4){0u, 0u, 0u, 0u};
    for (int i = gt; i < 9 * 2 * NVALID0 * 64; i += NGT) { const int c = i & 63, rr = (i >> 6) % NVALID0, gb = (i >> 6) / NVALID0, bb = gb & 1, grp = gb >> 1;
        *(u32x4*)((bf16_t*)(ws + WS_MIX + (size_t)grp * SZ_G) + ((size_t)bb * LSEQ + rr) * BW + c * 8) = z4; }
    for (int i = gt; i < 2 * NVALID0 * 128; i += NGT) { const int c = i & 127, rr = (i >> 7) % NVALID0, bb = (i >> 7) / NVALID0;
        *(u32x4*)((float*)(ws + WS_LOGF) + ((size_t)bb * LSEQ + rr) * BW + c * 4) = z4; }
    for (int i = gt; i < 2 * 1024 * 14; i += NGT) { const int c = i % 14, ch = i / 14;
        *(u32x4*)((bf16_t*)(ws + WS_IT) + (size_t)ch * LSEQ + c * 8) = z4; }
}

constexpr int N_ATT = 16 * NCH, N_HGL = 2 * NCH * 4, N_POOL = 2 * NCH * 4, N_CONV = 2 * NCH;
typedef __attribute__((address_space(1))) unsigned char gchar_t;
__device__ __forceinline__ unsigned char* launder(unsigned char* q) { gchar_t* g = (gchar_t*)q; asm volatile("" : "+s"(g)); return (unsigned char*)g; }
#define PH_COMMON \
    int tid_ = threadIdx.x; asm volatile("" : "+v"(tid_)); int G_ = gridDim.x, bid_ = blockIdx.x; asm volatile("" : "+s"(G_), "+s"(bid_)); \
    const int tid = tid_, lane = tid & 63, wave = __builtin_amdgcn_readfirstlane(tid >> 6); \
    const int G = G_, bid = bid_, gw = bid * NWAVES + wave, NGW = G * NWAVES; unsigned char* ws = launder(p.ws); (void)lane; (void)gw; (void)NGW; (void)tid; (void)ws;

__device__ __forceinline__ void ph_pro(const Params& p, LAS unsigned char* lds, int l) { PH_COMMON
    prologue_misc(p, gw, NGW, lane);
    zero_masked(ws, gw * 64 + lane, NGW * 64);
    convert_layer(p, 0, lds, gw, NGW, wave, lane, 0); }
__device__ __forceinline__ void ph_p1(const Params& p, LAS unsigned char* lds, int l) { PH_COMMON
    if (l > 0) zero_masked_g34(ws, gw * 64 + lane, NGW * 64);
    pg8::SchedPlain S; S.T.init(MROWS, INC); S.G = G; S.c = bid; S.A = (const char*)(ws + WS_XN); S.B = (const char*)(ws + WS_WIN); S.astep = (size_t)DM * 2; S.bstep = (size_t)256 * DM * 2;
    EpiIn E{ws, (const float*)(ws + WS_LB) + l * BW};
    pg8::gemm_phase(lds, tid, DM, DM, DM, S, E);
    { const int nt_ = (MROWS / 256) * (INC / 256), rem = nt_ % G;
      if (rem == 0 || rem == G) skinny_p1(ws, (const float*)(ws + WS_LB) + l * BW, lds, bid, G, tid, wave, lane);
      else if (bid >= rem) { skinny_p1(ws, (const float*)(ws + WS_LB) + l * BW, lds, bid - rem, G - rem, tid, wave, lane);
          if (l + 1 < DEPTH) convert_layer(p, l + 1, lds, (bid - rem) * NWAVES + wave, (G - rem) * NWAVES, wave, lane, 2); }
      if ((rem == 0 || rem == G) && l + 1 < DEPTH) convert_layer(p, l + 1, lds, gw, NGW, wave, lane, 2); } }
__device__ __forceinline__ void ph_p2a(const Params& p, LAS unsigned char* lds, int l) { PH_COMMON
#ifdef PROBE_K1
    unsigned long long t_last = __builtin_amdgcn_s_memrealtime(); unsigned long long* sub = (unsigned long long*)(ws + WS_CTL + 12288);
#define SUBSTAMP(i) do { __syncthreads(); if (bid == 0 && tid == 0) { const unsigned long long now_ = __builtin_amdgcn_s_memrealtime(); sub[i] += now_ - t_last; t_last = now_; } } while (0)
    for (int it = bid; it < N_HGL; it += G) hgrn2_local(ws, lds, it, tid, wave, lane);
    SUBSTAMP(0);
    for (int it = bid + ((N_HGL + G - 1 - bid) / G) * G; it < N_HGL + N_ATT; it += G) attn_item(ws, lds, it - N_HGL, wave, lane);
    SUBSTAMP(1);
#else
    constexpr int NA = N_HGL + N_ATT; const int nst = (NA / G >= 2) ? (NA / G - 1) * G : 0;
    volatile LAS int* bw = (volatile LAS int*)(lds + 147448); unsigned* ctr = (unsigned*)(ws + WS_CTL + 14336) + l;
    int it = bid; bool dyn = false;
    for (;;) {
        if (!dyn && it >= nst) dyn = true;
        if (dyn) { __syncthreads(); if (tid == 0) *bw = nst + (int)atomicAdd(ctr, 1u); __syncthreads(); it = *bw; }
        if (it >= NA) break;
        if (it < N_HGL) hgrn2_local(ws, lds, it, tid, wave, lane);
        else attn_item(ws, lds, it - N_HGL, wave, lane);
        if (!dyn) it += G;
    }
#endif
    }
__device__ __forceinline__ void ph_p2b(const Params& p, LAS unsigned char* lds, int l) { PH_COMMON
#ifdef PROBE_K1
    unsigned long long t_last = __builtin_amdgcn_s_memrealtime(); unsigned long long* sub = (unsigned long long*)(ws + WS_CTL + 12288);
#endif
    hgrn2_scan(ws, gw * 64 + lane, NGW * 64);
#ifdef PROBE_K1
    SUBSTAMP(2);
#endif
    {
        constexpr int NB = N_POOL + N_CONV; const int nst = (NB / G >= 2) ? (NB / G - 1) * G : 0;
        volatile LAS int* bw = (volatile LAS int*)(lds + 147448); unsigned* ctr = (unsigned*)(ws + WS_CTL + 14336) + 4 + l;
        int it = bid; bool dyn = false;
        for (;;) {
            if (!dyn && it >= nst) dyn = true;
            if (dyn) { __syncthreads(); if (tid == 0) *bw = nst + (int)atomicAdd(ctr, 1u); __syncthreads(); it = *bw; }
            if (it >= NB) break;
            if (it < N_CONV) conv_item(ws, p.conv_w + (size_t)l * 3 * BW, it, tid);
            else pool_item(ws, l, it - N_CONV, wave, lane);
            if (!dyn) it += G;
        }
    }
#ifdef PROBE_K1
    SUBSTAMP(3);
#endif
    if (l + 1 < DEPTH) convert_layer(p, l + 1, lds, gw, NGW, wave, lane, 1);
#ifdef PROBE_K1
    SUBSTAMP(4);
#endif
    }
__device__ __forceinline__ void ph_p2c(const Params& p, LAS unsigned char* lds, int l) { PH_COMMON
    {
        const int nst = (N_HGL / G >= 2) ? (N_HGL / G - 1) * G : 0;
        volatile LAS int* bw = (volatile LAS int*)(lds + 147448); unsigned* ctr = (unsigned*)(ws + WS_CTL + 14336) + 8 + l;
        int it = bid; bool dyn = false;
        for (;;) {
            if (!dyn && it >= nst) dyn = true;
            if (dyn) { __syncthreads(); if (tid == 0) *bw = nst + (int)atomicAdd(ctr, 1u); __syncthreads(); it = *bw; }
            if (it >= N_HGL) break;
            hgrn2_out(ws, p.hg_norm_g + l * BW, lds, it, tid, wave, lane);
            if (!dyn) it += G;
        }
    } }
__device__ __forceinline__ void ph_p3(const Params& p, LAS unsigned char* lds, int l) { PH_COMMON
    const size_t wo = (l & 1) ? W2_OFF : 0;
    pg8::SchedBranch S; S.T.init(MROWS, DM); S.G = G; S.c = bid;
    S.A0 = (const char*)(ws + WS_MIX); S.A1 = (const char*)(ws + WS_POOLO); S.A2 = (const char*)(ws + WS_MIX + SZ_G); S.A3 = (const char*)(ws + WS_MIX + 2 * SZ_G);
    S.B = (const char*)(ws + WS_WBR + wo); S.astep = (size_t)BW * 2; S.bstep = (size_t)256 * BW * 2; S.bz = (size_t)DM * BW * 2;
    EpiBranch E{ws};
    pg8::gemm_phase(lds, tid, BW, BW, BW, S, E);
    skinny_p3(ws, wo, lds, bid, G, tid, wave, lane); }
__device__ __forceinline__ void ph_p4(const Params& p, LAS unsigned char* lds, int l) { PH_COMMON
    const size_t wo = (l & 1) ? W2_OFF : 0;
    pg8::SchedPlain S; S.T.init(MROWS, DM); S.G = G; S.c = bid; S.A = (const char*)(ws + WS_MIXEDB); S.B = (const char*)(ws + WS_WO + wo); S.astep = (size_t)DM * 2; S.bstep = (size_t)256 * DM * 2;
    EpiResid E{ws, (float*)(ws + WS_ST2)};
    pg8::gemm_phase(lds, tid, DM, DM, DM, S, E);
    skinny_resid(ws, WS_MIXEDB, DM, DM, WS_WO + wo, lds, bid, G, tid, wave, lane); }
__device__ __forceinline__ void ph_p5(const Params& p, LAS unsigned char* lds, int l) { PH_COMMON
    const size_t wo = (l & 1) ? W2_OFF : 0;
    pg8::SchedPlain S; S.T.init(MROWS, DFF); S.G = G; S.c = bid; S.A = (const char*)(ws + WS_XN); S.B = (const char*)(ws + WS_WUP + wo); S.astep = (size_t)DM * 2; S.bstep = (size_t)256 * DM * 2;
    EpiUp E{ws};
    pg8::gemm_phase(lds, tid, DM, DM, DM, S, E);
    skinny_p5(ws, wo, lds, bid, G, tid, wave, lane); }
__device__ __forceinline__ void ph_p6(const Params& p, LAS unsigned char* lds, int l) { PH_COMMON
    const size_t wo = (l & 1) ? W2_OFF : 0;
    pg8::SchedPlain S; S.T.init(MROWS, DM); S.G = G; S.c = bid; S.A = (const char*)(ws + WS_H); S.B = (const char*)(ws + WS_WDN + wo); S.astep = (size_t)PF * 2; S.bstep = (size_t)256 * PF * 2;
    EpiResid E{ws, (float*)(ws + WS_ST1)};
    pg8::gemm_phase(lds, tid, PF, PF, DFF, S, E);
    skinny_resid(ws, WS_H, DFF, PF, WS_WDN + wo, lds, bid, G, tid, wave, lane); }
__device__ __forceinline__ void ph_fin(const Params& p, LAS unsigned char* lds, int l) { PH_COMMON
    final_norm(p, gw, NGW, lane); }

#ifndef MEGA
#define MEGA 1
#endif
#ifdef DIAG
__global__ void k_chk(const unsigned char* base, size_t nbytes, int isf32, int code, unsigned* flag) {
    const size_t n = nbytes / 4; const unsigned* w = (const unsigned*)base; bool bad = false;
    for (size_t i = (size_t)blockIdx.x * blockDim.x + threadIdx.x; i < n; i += (size_t)gridDim.x * blockDim.x) {
        const unsigned u = w[i];
        if (isf32) bad |= (u & 0x7F800000u) == 0x7F800000u;
        else bad |= ((u & 0x7F80u) == 0x7F80u) || ((u & 0x7F800000u) == 0x7F800000u);
    }
    if (bad) atomicMin(flag, (unsigned)code);
}
__global__ void k_flaginit(unsigned* flag) { if (threadIdx.x == 0 && blockIdx.x == 0) *flag = 99u; }
__global__ void k_flagout(const unsigned* flag, float* out, size_t n) {
    const unsigned f = *flag; if (f == 99u) return;
    for (size_t i = (size_t)blockIdx.x * blockDim.x + threadIdx.x; i < n; i += (size_t)gridDim.x * blockDim.x) out[i] = (float)f;
}

#endif
#define XB_TMO      128
#define XB_XCNT(j)  (256  + 64 * (j))
#define XB_XSUB(j)  (1280 + 64 * (j))
#define XB_XGEN(j)  (2304 + 64 * (j))
#define XB_TOP      3328
#define XB_TOPGEN   3392
#define XCD_BAR_WORDS 3456
#define XB_SPIN_CAP (1u << 22)
__device__ __forceinline__ unsigned xb_ld(unsigned* p)              { return __hip_atomic_load(p, __ATOMIC_RELAXED, __HIP_MEMORY_SCOPE_AGENT); }
__device__ __forceinline__ unsigned xb_add(unsigned* p, unsigned v) { return __hip_atomic_fetch_add(p, v, __ATOMIC_RELAXED, __HIP_MEMORY_SCOPE_AGENT); }
__device__ __forceinline__ unsigned xb_xcc_id() { return (unsigned)__builtin_amdgcn_s_getreg((3 << 11) | 20) & 0xFu; }
#define XB_SPIN(cond, bar) do { unsigned _sp = 0; while (cond) { __builtin_amdgcn_s_sleep(1); \
    if ((++_sp & 255u) == 0u) { if (xb_ld(&(bar)[XB_TMO])) break; if (_sp > XB_SPIN_CAP) { atomicAdd(&(bar)[XB_TMO], 1u); break; } } } } while (0)
struct XcdBarrier { unsigned* bar; unsigned x; volatile LAS unsigned* st; };
__device__ __forceinline__ XcdBarrier xcd_barrier_post(unsigned* bar, volatile LAS unsigned* st) {
    XcdBarrier b; b.bar = bar; b.x = xb_xcc_id(); b.st = st;
    if (threadIdx.x == 0) (void)xb_add(&bar[XB_XCNT(b.x)], 1u);
    return b;
}
__device__ __forceinline__ void xcd_barrier_complete(unsigned* bar, unsigned x, unsigned& nloc, unsigned& nx) {
    const unsigned G = gridDim.x * gridDim.y * gridDim.z;
    unsigned sum, cnt, mine, sp = 0u;
    for (;;) {
        sum = 0u; cnt = 0u; mine = 0u;
#pragma unroll
        for (unsigned j = 0; j < 16; ++j) { const unsigned c = xb_ld(&bar[XB_XCNT(j)]); sum += c; cnt += (c > 0u) ? 1u : 0u; mine = (j == x) ? c : mine; }
        if (sum == G) break;
        __builtin_amdgcn_s_sleep(1);
        if ((++sp & 255u) == 0u) { if (xb_ld(&bar[XB_TMO])) break; if (sp > XB_SPIN_CAP) { atomicAdd(&bar[XB_TMO], 1u); break; } }
    }
    nloc = mine > 0u ? mine : 1u; nx = cnt > 0u ? cnt : 1u;
}
__device__ __forceinline__ void xcd_barrier(const XcdBarrier& b) {
    asm volatile("s_waitcnt vmcnt(0)" ::: "memory");
    __syncthreads();
    if (threadIdx.x == 0) {
        unsigned* bar = b.bar;
        __builtin_amdgcn_s_waitcnt(0);
        unsigned nloc = b.st[0], nx = b.st[1];
        if (nloc == 0u) { xcd_barrier_complete(bar, b.x, nloc, nx); b.st[0] = nloc; b.st[1] = nx; }
        const unsigned old = xb_add(&bar[XB_XSUB(b.x)], 1u);
        const unsigned gen = old / nloc;
        if (old + 1u == (gen + 1u) * nloc) {
            __builtin_amdgcn_fence(__ATOMIC_RELEASE, "agent");
            asm volatile("s_waitcnt vmcnt(0)" ::: "memory");
            const unsigned og = xb_add(&bar[XB_TOP], 1u);
            const unsigned tg = og / nx;
            if (og + 1u == (tg + 1u) * nx) xb_add(&bar[XB_TOPGEN], 1u);
            else XB_SPIN(xb_ld(&bar[XB_TOPGEN]) == tg, bar);
            __builtin_amdgcn_fence(__ATOMIC_ACQUIRE, "agent");
            xb_add(&bar[XB_XGEN(b.x)], 1u);
            asm volatile("s_waitcnt vmcnt(0)" ::: "memory");
        } else {
            XB_SPIN(xb_ld(&bar[XB_XGEN(b.x)]) == gen, bar);
            __builtin_amdgcn_fence(__ATOMIC_ACQUIRE, "agent");
            asm volatile("s_waitcnt vmcnt(0)" ::: "memory");
        }
    }
    __syncthreads();
}

#if MEGA
__global__ void __launch_bounds__(NT, 2) fwd_megakernel(Params p) {
    extern __shared__ __attribute__((aligned(16))) unsigned char lds_raw[];
    LAS unsigned char* lds = (LAS unsigned char*)lds_raw;
    cg::grid_group grid = cg::this_grid();
    volatile LAS unsigned* bst = (volatile LAS unsigned*)(lds + 147440);
    if (threadIdx.x == 0) { bst[0] = 0u; bst[1] = 0u; }
    __syncthreads();
    const XcdBarrier bar = xcd_barrier_post((unsigned*)(p.ws + WS_CTL), bst);
#ifdef PROBE_K1
    if (blockIdx.x == 0 && threadIdx.x == 0) ((unsigned long long*)(p.ws + WS_CTL + 8192))[0] = __builtin_amdgcn_s_memrealtime();
#endif
#pragma unroll 1
    for (int ph = 0; ph < 1 + DEPTH * 8; ++ph) {
        const int l = ph == 0 ? 0 : (ph - 1) >> 3, k = ph == 0 ? 0 : (ph - 1) & 7;
        if (ph == 0) ph_pro(p, lds, 0);
        else if (k == 0) ph_p1(p, lds, l);
        else if (k == 1) ph_p2a(p, lds, l);
        else if (k == 2) ph_p2b(p, lds, l);
        else if (k == 3) ph_p2c(p, lds, l);
        else if (k == 4) ph_p3(p, lds, l);
        else if (k == 5) ph_p4(p, lds, l);
        else if (k == 6) ph_p5(p, lds, l);
        else ph_p6(p, lds, l);
        xcd_barrier(bar);
        if (p.ws == nullptr) grid.sync();
#ifdef PROBE_K1
        if (blockIdx.x == 0 && threadIdx.x == 0) ((unsigned long long*)(p.ws + WS_CTL + 8192))[ph + 1] = __builtin_amdgcn_s_memrealtime();
#endif
    }
#ifdef PROBE_K1
    __syncthreads();
#endif
    ph_fin(p, lds, 0);
}
#else
#define MKK(NAME, FN) __global__ void __launch_bounds__(NT, 2) NAME(Params p, int l) { \
    extern __shared__ __attribute__((aligned(16))) unsigned char lds_raw[]; FN(p, (LAS unsigned char*)lds_raw, l); }
MKK(k_pro, ph_pro) MKK(k_p1, ph_p1) MKK(k_p2a, ph_p2a) MKK(k_p2b, ph_p2b) MKK(k_p2c, ph_p2c) MKK(k_p3, ph_p3) MKK(k_p4, ph_p4) MKK(k_p5, ph_p5) MKK(k_p6, ph_p6) MKK(k_fin, ph_fin)
__device__ __forceinline__ void ph_poolonly(const Params& p, LAS unsigned char* lds, int l) { PH_COMMON
    for (int it = bid; it < N_POOL; it += G) pool_item(ws, l, it, wave, lane); }
MKK(k_poolonly, ph_poolonly)
#endif

extern "C" void kernel_launch(void* const* d_in, const int* in_sizes, int n_in, void* d_out, int out_size, void* d_ws, size_t ws_size, hipStream_t stream) {
    static int grid = 0;
    if (grid == 0) {
        int dev = 0, cus = 0;
        (void)hipGetDevice(&dev); (void)hipDeviceGetAttribute(&cus, hipDeviceAttributeMultiprocessorCount, dev);
#if MEGA
        int per = 0;
        (void)hipFuncSetAttribute((const void*)fwd_megakernel, hipFuncAttributeMaxDynamicSharedMemorySize, LDS_BYTES);
        (void)hipOccupancyMaxActiveBlocksPerMultiprocessor(&per, (const void*)fwd_megakernel, NT, LDS_BYTES);
        if (per < 1) per = 1;
        grid = cus * per;
#else
        const void* ks[] = {(const void*)k_pro, (const void*)k_p1, (const void*)k_p2a, (const void*)k_p2b, (const void*)k_p2c, (const void*)k_p3, (const void*)k_p4, (const void*)k_p5, (const void*)k_p6, (const void*)k_fin};
        for (int i = 0; i < 10; ++i) (void)hipFuncSetAttribute(ks[i], hipFuncAttributeMaxDynamicSharedMemorySize, LDS_BYTES);
        grid = cus;
#endif
        if (n_in != 15 || ws_size < WS_END) { fprintf(stderr, "kernel_launch: unexpected n_in %d / ws %zu (need %zu)\n", n_in, ws_size, (size_t)WS_END); }
    }
    Params p{};
    p.x = (const float*)d_in[0]; p.meta = (const float*)d_in[1]; p.lb_logits = (const float*)d_in[2]; p.norm1_g = (const float*)d_in[3]; p.w_in = (const float*)d_in[4];
    p.hg_norm_g = (const float*)d_in[5]; p.pool_w = (const float*)d_in[6]; p.pool_scale = (const float*)d_in[7]; p.conv_w = (const float*)d_in[8]; p.w_branch = (const float*)d_in[9];
    p.w_o = (const float*)d_in[10]; p.norm2_g = (const float*)d_in[11]; p.w_up = (const float*)d_in[12]; p.w_down = (const float*)d_in[13]; p.final_g = (const float*)d_in[14];
    p.out = (float*)d_out; p.ws = (unsigned char*)d_ws;
#if MEGA
    (void)hipMemsetAsync((char*)d_ws + WS_CTL, 0, 16384, stream);
    void* args[] = {&p};
    hipError_t e = hipLaunchCooperativeKernel((void*)fwd_megakernel, dim3(grid), dim3(NT), args, LDS_BYTES, stream);
    if (e != hipSuccess) fprintf(stderr, "cooperative launch failed: %s (grid %d)\n", hipGetErrorString(e), grid);
#else
#define LK(K, L) hipLaunchKernelGGL(K, dim3(grid), dim3(NT), LDS_BYTES, stream, p, (int)(L))
#ifdef DIAG
    unsigned char* W = (unsigned char*)d_ws; unsigned* flag = (unsigned*)(W + WS_END + 4096);
#define CHK(off, bytes, f32, code) hipLaunchKernelGGL(k_chk, dim3(1024), dim3(256), 0, stream, (const unsigned char*)(W + (off)), (size_t)(bytes), (int)(f32), (int)(code), flag)
    hipLaunchKernelGGL(k_flaginit, dim3(1), dim3(64), 0, stream, flag);
    LK(k_pro, 0);
    CHK(WS_X, (size_t)ROWS * DM * 4, 1, 1); CHK(WS_XN, (size_t)ROWS * DM * 2, 0, 1); CHK(WS_WIN, WS_X - WS_WIN, 0, 1); CHK(WS_LB, WS_DEC, 1, 1); CHK(WS_ST1, (size_t)ROWS * 64, 1, 1);
    LK(k_p1, 0);
    CHK(WS_MIX, 9 * SZ_G, 0, 2); CHK(WS_IT, 2 * SZ_G, 0, 3); CHK(WS_GATE, (size_t)ROWS * DFF * 2, 0, 4); CHK(WS_LOGF, (size_t)ROWS * BW * 4, 1, 5);
    CHK(WS_PWT, 4 * 4 * 128 * 128 * 2, 0, 1);
    LK(k_poolonly, 0);
    CHK(WS_POOLO, SZ_G, 0, 6);
    LK(k_p2a, 0);
    CHK(WS_POOLO, SZ_G, 0, 16); CHK(WS_DS, (size_t)ROWS * BW * 4, 1, 7); CHK(WS_LOGF, (size_t)ROWS * BW * 4, 1, 8); CHK(WS_MIX + SZ_G, 2 * SZ_G, 0, 9);
    LK(k_p2b, 0);
    CHK(WS_SPREV, SZ_G, 0, 10);
    LK(k_p2c, 0);
    CHK(WS_MIX, SZ_G, 0, 11);
    LK(k_p3, 0);
    CHK(WS_MIXEDB, 2 * SZ_G, 0, 12);
    LK(k_p4, 0);
    CHK(WS_X, (size_t)ROWS * DM * 4, 1, 13);
    LK(k_p5, 0);
    CHK(WS_H, (size_t)ROWS * DFF * 2, 0, 14);
    LK(k_p6, 0);
    CHK(WS_X, (size_t)ROWS * DM * 4, 1, 15);
    LK(k_fin, 0);
    hipLaunchKernelGGL(k_flagout, dim3(1024), dim3(256), 0, stream, (const unsigned*)flag, (float*)d_out, (size_t)BATCH * SEQ * DM);
#else
    LK(k_pro, 0);
    for (int l = 0; l < DEPTH; ++l) {
        LK(k_p1, l); LK(k_p2a, l); LK(k_p2b, l); LK(k_p2c, l); LK(k_p3, l); LK(k_p4, l); LK(k_p5, l); LK(k_p6, l);
    }
    LK(k_fin, 0);
#endif
#endif
}
```

```cpp
#define MEGA 1
#include <hip/hip_runtime.h>
#include <hip/hip_cooperative_groups.h>
#include <cstdio>
#include <cstdint>
namespace cg = cooperative_groups;

#define LAS __attribute__((address_space(3)))
typedef unsigned short bf16_t;
typedef short bf16x8 __attribute__((ext_vector_type(8)));
typedef float f32x4 __attribute__((ext_vector_type(4)));
typedef float f32x2 __attribute__((ext_vector_type(2)));
typedef unsigned u32x4 __attribute__((ext_vector_type(4)));
typedef unsigned u32x2 __attribute__((ext_vector_type(2)));

constexpr int DM = 1024, BATCH = 2, SEQ = 8192, DEPTH = 4, FRONT = 128, NVALID0 = 112, LSEQ = 8320, ROWS = BATCH * LSEQ;
constexpr int BW = 512, INC = 9728, DFF = 4096, NCH = 65;
constexpr float EPS = 1e-6f;
constexpr int NT = 512, NWAVES = 8;
constexpr int PF = DFF + 64;
constexpr int MROWS = BATCH * SEQ;

constexpr size_t al(size_t x) { return (x + 4095) & ~(size_t)4095; }
constexpr size_t SZ_G = (size_t)ROWS * BW * 2;
constexpr size_t WS_LB = 0;
constexpr size_t WS_PWT = al(WS_LB + 4 * 512 * 4);
constexpr size_t WS_DEC = al(WS_PWT + 4 * 4 * 128 * 128 * 2);
constexpr size_t WS_ST1 = al(WS_DEC + 2 * 65 * 4 * 128 * 4);
constexpr size_t WS_ST2 = al(WS_ST1 + (size_t)ROWS * 16 * 4);
constexpr size_t WS_WIN = al(WS_ST2 + (size_t)ROWS * 16 * 4);
constexpr size_t WS_WBR = al(WS_WIN + (size_t)INC * DM * 2);
constexpr size_t WS_WO = al(WS_WBR + (size_t)4 * DM * BW * 2);
constexpr size_t WS_WUP = al(WS_WO + (size_t)DM * DM * 2);
constexpr size_t WS_WDN = al(WS_WUP + (size_t)DFF * DM * 2);
constexpr size_t WS_X = al(WS_WDN + (size_t)PF * DM * 2);
constexpr size_t WS_XN = al(WS_X + (size_t)ROWS * DM * 4);
constexpr size_t WS_MIX = al(WS_XN + (size_t)ROWS * DM * 2);
constexpr size_t WS_MIXEDB = WS_MIX + 3 * SZ_G;
constexpr size_t WS_POOLO = al(WS_MIX + 9 * SZ_G);
constexpr size_t WS_IT = al(WS_POOLO + SZ_G);
constexpr size_t WS_VT = al(WS_IT + SZ_G);
constexpr size_t WS_GATE = al(WS_VT + SZ_G);
constexpr size_t WS_H = WS_GATE;
constexpr size_t WS_LOGF = al(WS_GATE + (size_t)ROWS * PF * 2);
constexpr size_t WS_DS = WS_LOGF + (size_t)ROWS * BW * 4;
constexpr size_t WS_MIXEDF = WS_LOGF;
constexpr size_t WS_SPREV = al(WS_DS + (size_t)ROWS * BW * 4);
constexpr size_t WS_CTL = al(WS_SPREV + SZ_G);
constexpr size_t WS_W2 = WS_CTL + 16384;
constexpr size_t W2_OFF = WS_W2 - WS_WBR;
constexpr size_t WS_END = WS_W2 + (WS_X - WS_WBR);
static_assert(WS_DS + (size_t)ROWS * BW * 4 == WS_MIXEDF + (size_t)ROWS * DM * 4, "MIXEDF overlay");

constexpr int LDS_BYTES = 147456;

typedef __bf16 bf16x2_t __attribute__((ext_vector_type(2)));
__device__ __forceinline__ unsigned cvt_pk_bf16(float lo, float hi) { const f32x2 v = {lo, hi}; return __builtin_bit_cast(unsigned, __builtin_convertvector(v, bf16x2_t)); }
__device__ __forceinline__ float bflo(unsigned w) { return __uint_as_float(w << 16); }
__device__ __forceinline__ float bfhi(unsigned w) { return __uint_as_float(w & 0xffff0000u); }
__device__ __forceinline__ float bf2f(bf16_t u) { return __uint_as_float(((unsigned)u) << 16); }
__device__ __forceinline__ bf16_t f2bf(float f) { return (bf16_t)(cvt_pk_bf16(f, 0.f) & 0xffffu); }
__device__ __forceinline__ float sigmoidf_(float v) { return __builtin_amdgcn_rcpf(1.0f + __expf(-v)); }
__device__ __forceinline__ float wave_sum(float v) {
#pragma unroll
    for (int o = 1; o < 64; o <<= 1) v += __shfl_xor(v, o);
    return v;
}
__device__ __forceinline__ void unpack8(const u32x4 w, float (&f)[8]) {
    f[0] = bflo(w.x); f[1] = bfhi(w.x); f[2] = bflo(w.y); f[3] = bfhi(w.y); f[4] = bflo(w.z); f[5] = bfhi(w.z); f[6] = bflo(w.w); f[7] = bfhi(w.w);
}
__device__ __forceinline__ bf16x8 pack8(const float (&f)[8]) {
    u32x4 w; w.x = cvt_pk_bf16(f[0], f[1]); w.y = cvt_pk_bf16(f[2], f[3]); w.z = cvt_pk_bf16(f[4], f[5]); w.w = cvt_pk_bf16(f[6], f[7]);
    return __builtin_bit_cast(bf16x8, w);
}
#define MFMA16(a, b, c) __builtin_amdgcn_mfma_f32_16x16x32_bf16((a), (b), (c), 0, 0, 0)

struct Params {
    const float *x, *meta, *lb_logits, *norm1_g, *w_in, *hg_norm_g, *pool_w, *pool_scale, *conv_w, *w_branch, *w_o, *norm2_g, *w_up, *w_down, *final_g;
    float* out; unsigned char* ws;
};
namespace pg8 {
constexpr int BM = 256, BK = 64, HALF = 128, HTB = HALF * BK * 2, STAGE_BYTES = 8 * HTB, NXCD = 8, WGM = 8;
__device__ __forceinline__ int lds_byte(int r, int c) { const int st = (r >> 4) * 2 + (c >> 5), rr = r & 15, cc = c & 31, ob = rr * 64 + cc * 2; return st * 1024 + (ob ^ (((ob >> 9) & 1) << 5)); }
__device__ __forceinline__ void stage_rc(int b, int& R, int& C) { const int st = b / 1024, sb = b % 1024, swz = sb ^ (((sb >> 9) & 1) << 5); R = (st >> 1) * 16 + swz / 64; C = (st & 1) * 32 + (swz % 64) / 2; }
__device__ __forceinline__ int perm32(int rho) { const int n = rho >> 4, i = rho & 15; return 8 * (i >> 2) + 4 * n + (i & 3); }

struct Unit { int pm, pn, z; const char* a; const char* b; };
__device__ __forceinline__ int rowbase(int pm) { return (pm >> 5) * LSEQ + FRONT + (pm & 31) * 256; }

struct TileOrder {
    int nM, nN, nwg;
    __device__ __forceinline__ void init(int M, int N) { nM = M / BM; nN = N / BM; nwg = nM * nN; }
    __device__ __forceinline__ bool tile(long L, int& pm, int& pn) const {
        if (L >= nwg) return false;
        int wgid = (int)L; { const int q = nwg / NXCD, r = nwg % NXCD, xcd = wgid % NXCD, off = wgid / NXCD; wgid = (xcd < r ? xcd * (q + 1) : r * (q + 1) + (xcd - r) * q) + off; }
        const int nig = WGM * nN, gid = wgid / nig, fm = gid * WGM, gsz = (nM - fm) < WGM ? (nM - fm) : WGM;
        pm = fm + ((wgid % nig) % gsz); pn = (wgid % nig) / gsz; return true;
    }
};
struct SchedPlain {
    TileOrder T; int G, c; const char* A; const char* B; size_t astep, bstep;
    __device__ __forceinline__ bool next(int i, Unit& u) const {
        if (!T.tile((long)i * G + c, u.pm, u.pn)) return false;
        u.z = 0; u.a = A + (size_t)rowbase(u.pm) * astep; u.b = B + (size_t)u.pn * bstep; return true;
    }
};
struct SchedBranch {
    TileOrder T; int G, c; const char *A0, *A1, *A2, *A3; const char* B; size_t astep, bstep, bz;
    __device__ __forceinline__ bool next(int i, Unit& u) const {
        if (!T.tile((long)(i >> 2) * G + c, u.pm, u.pn)) return false;
        u.z = i & 3; const char* ab = u.z == 0 ? A0 : (u.z == 1 ? A1 : (u.z == 2 ? A2 : A3));
        u.a = ab + (size_t)rowbase(u.pm) * astep; u.b = B + (size_t)u.z * bz + (size_t)u.pn * bstep; return true;
    }
};

template <class Epi, class Sched>
__device__ __forceinline__ void gemm_phase(LAS unsigned char* lds, const int tid, const int lda, const int ldb, const int K, const Sched& S, const Epi& E) {
    const int wid = __builtin_amdgcn_readfirstlane(tid >> 6), lane = tid & 63, wr = wid >> 2, wc = wid & 3, fr = lane & 15, fq = lane >> 4;
    const int nt = K / BK;
    unsigned voffA[2], voffB[2];
#pragma unroll
    for (int i = 0; i < 2; ++i) { int R, C; stage_rc(tid * 16 + i * 8192, R, C); const int Rb = Epi::PERM ? ((R & ~31) + perm32(R & 31)) : R;
        voffA[i] = (unsigned)(R * lda + C) * 2u; voffB[i] = (unsigned)(Rb * ldb + C) * 2u; }
    const size_t kstep = (size_t)(BK * 2);
    const size_t hstepA = (size_t)HALF * lda * 2, hstepB = (size_t)HALF * ldb * 2;
    const unsigned ldsw = (unsigned)wid * 1024u;
    const int aoff = lds_byte(wr * 64 + fr, fq * 8), boff = lds_byte(wc * 32 + fr, fq * 8);
#define PG8_SA(b, h) (((b) * 2 + (h)) * HTB)
#define PG8_SB(b, h) ((4 + (b) * 2 + (h)) * HTB)
#define PG8_STAGE(bufoff, gbase, voff) do { _Pragma("unroll") for (int _i = 0; _i < 2; ++_i) \
        __builtin_amdgcn_global_load_lds((const unsigned*)((const char*)(gbase) + (voff)[_i]), (LAS unsigned*)(lds + (bufoff) + ldsw + _i * 8192), 16, 0, 0); } while (0)
#define PG8_LDA(dst, b, h) do { _Pragma("unroll") for (int m = 0; m < 4; ++m) _Pragma("unroll") for (int k = 0; k < 2; ++k) dst[m][k] = *(const LAS bf16x8*)(lds + PG8_SA(b, h) + aoff + m * 2048 + k * 1024); } while (0)
#define PG8_LDB(dst, b, h) do { _Pragma("unroll") for (int n = 0; n < 2; ++n) _Pragma("unroll") for (int k = 0; k < 2; ++k) dst[n][k] = *(const LAS bf16x8*)(lds + PG8_SB(b, h) + boff + n * 2048 + k * 1024); } while (0)
#define PG8_MMA(ai, bj, At, Bt) do { __builtin_amdgcn_s_setprio(1); _Pragma("unroll") for (int m = 0; m < 4; ++m) _Pragma("unroll") for (int n = 0; n < 2; ++n) _Pragma("unroll") for (int k = 0; k < 2; ++k) \
        acc[ai][bj][m][n] = __builtin_amdgcn_mfma_f32_16x16x32_bf16(Bt[n][k], At[m][k], acc[ai][bj][m][n], 0, 0, 0); __builtin_amdgcn_s_setprio(0); } while (0)
#define PG8_WAIT_V(n) asm volatile("s_waitcnt vmcnt(" #n ")" ::: "memory")
#define PG8_WAIT_L(n) asm volatile("s_waitcnt lgkmcnt(" #n ")" ::: "memory")
#define PG8_BAR __builtin_amdgcn_s_barrier()
#define PG8_SCHED __builtin_amdgcn_sched_barrier(0)
    Unit cur, nxt; int ui = 0;
    if (!S.next(0, cur)) return;
    f32x4 acc[2][2][4][2];
#pragma unroll
    for (int a = 0; a < 2; ++a)
#pragma unroll
        for (int b = 0; b < 2; ++b)
#pragma unroll
            for (int m = 0; m < 4; ++m)
#pragma unroll
                for (int n = 0; n < 2; ++n) acc[a][b][m][n] = (f32x4){0.f, 0.f, 0.f, 0.f};
    bf16x8 At[4][2], B0[2][2], B1[2][2];
    const char* cA = cur.a; const char* cB = cur.b;
    PG8_STAGE(PG8_SB(0, 0), cB, voffB); PG8_STAGE(PG8_SB(0, 1), cB + hstepB, voffB); PG8_STAGE(PG8_SA(0, 0), cA, voffA); PG8_STAGE(PG8_SA(0, 1), cA + hstepA, voffA);
    if (wr == 1) PG8_BAR;
    PG8_WAIT_V(2); PG8_BAR;
    PG8_STAGE(PG8_SB(1, 0), cB + kstep, voffB); PG8_STAGE(PG8_SA(1, 0), cA + kstep, voffA); PG8_STAGE(PG8_SB(1, 1), cB + hstepB + kstep, voffB);
    PG8_WAIT_V(6); PG8_BAR;
    for (;;) {
        const bool has_next = S.next(ui + 1, nxt);
        const char* nA = has_next ? nxt.a : cA; const char* nB = has_next ? nxt.b : cB;
        for (int t = 0; t < nt; t += 2) {
            const bool last = (t == nt - 2);
            const char* a1 = cA + (size_t)(t + 1) * kstep;
            const char* a2 = last ? nA : cA + (size_t)(t + 2) * kstep; const char* b2 = last ? nB : cB + (size_t)(t + 2) * kstep;
            const char* a3 = a2 + kstep; const char* b3 = b2 + kstep;
            PG8_LDB(B0, 0, 0); PG8_LDB(B1, 0, 1); PG8_SCHED; PG8_LDA(At, 0, 0); PG8_STAGE(PG8_SA(1, 1), a1 + hstepA, voffA);
            PG8_WAIT_V(8); PG8_WAIT_L(0); PG8_BAR; PG8_MMA(0, 0, At, B0); PG8_MMA(0, 1, At, B1); PG8_BAR; PG8_SCHED;
            PG8_LDA(At, 0, 1); PG8_STAGE(PG8_SB(0, 0), b2, voffB); PG8_STAGE(PG8_SB(0, 1), b2 + hstepB, voffB); PG8_STAGE(PG8_SA(0, 0), a2, voffA);
            PG8_WAIT_V(8); PG8_WAIT_L(0); PG8_BAR; PG8_MMA(1, 0, At, B0); PG8_MMA(1, 1, At, B1); PG8_BAR; PG8_SCHED;
            PG8_LDB(B0, 1, 0); PG8_LDB(B1, 1, 1); PG8_SCHED; PG8_LDA(At, 1, 0); PG8_STAGE(PG8_SA(0, 1), a2 + hstepA, voffA);
            PG8_WAIT_V(8); PG8_WAIT_L(0); PG8_BAR; PG8_MMA(0, 0, At, B0); PG8_MMA(0, 1, At, B1); PG8_BAR; PG8_SCHED;
            PG8_LDA(At, 1, 1); PG8_STAGE(PG8_SB(1, 0), b3, voffB); PG8_STAGE(PG8_SB(1, 1), b3 + hstepB, voffB); PG8_STAGE(PG8_SA(1, 0), a3, voffA);
            PG8_WAIT_V(8); PG8_WAIT_L(0); PG8_BAR; PG8_MMA(1, 0, At, B0); PG8_MMA(1, 1, At, B1); PG8_BAR; PG8_SCHED;
        }
        if (wr == 0) PG8_BAR;
        E(acc, cur, wr, wc, fr, fq);
        if (!has_next) break;
        if (!Epi::KEEP || cur.z == 3)
#pragma unroll
        for (int a = 0; a < 2; ++a)
#pragma unroll
            for (int b = 0; b < 2; ++b)
#pragma unroll
                for (int m = 0; m < 4; ++m)
#pragma unroll
                    for (int n = 0; n < 2; ++n) acc[a][b][m][n] = (f32x4){0.f, 0.f, 0.f, 0.f};
        cur = nxt; cA = nA; cB = nB; ++ui;
        if (wr == 1) PG8_BAR;
    }
    PG8_WAIT_V(0);
    PG8_BAR;
#undef PG8_SA
#undef PG8_SB
#undef PG8_STAGE
#undef PG8_LDA
#undef PG8_LDB
#undef PG8_MMA
#undef PG8_WAIT_V
#undef PG8_WAIT_L
#undef PG8_BAR
#undef PG8_SCHED
}
}
using pg8::Unit;

__device__ __forceinline__ float row_rstd(const float* st, int row) {
    const f32x4* p = (const f32x4*)(st + (size_t)row * 16);
    const f32x4 a = p[0], b = p[1], c = p[2], d = p[3];
    const float s = ((a.x + a.y) + (a.z + a.w)) + ((b.x + b.y) + (b.z + b.w)) + ((c.x + c.y) + (c.z + c.w)) + ((d.x + d.y) + (d.z + d.w));
    return rsqrtf(s * (1.0f / DM) + EPS);
}

struct EpiIn {
    static constexpr bool PERM = true, KEEP = false;
    unsigned char* ws; const float* lb;
    __device__ __forceinline__ void operator()(f32x4 (&acc)[2][2][4][2], const Unit& u, int wr, int wc, int fr, int fq) const {
        const float* st = (const float*)(ws + WS_ST1);
        const int cgp = u.pn >> 1;
        const int ccb = (u.pn & 1) * 256 + wc * 32 + 8 * fq;
        int dstg = -1;
        if (cgp == 0) dstg = 0; else if (cgp == 1) dstg = 3; else if (cgp == 3) dstg = 4; else if (cgp == 4) dstg = 5; else if (cgp == 5) dstg = 1;
        else if (cgp == 6) dstg = 6; else if (cgp == 8) dstg = 7; else if (cgp == 9) dstg = 2; else if (cgp == 10) dstg = 8;
#pragma unroll
        for (int ai = 0; ai < 2; ++ai)
#pragma unroll
            for (int m = 0; m < 4; ++m) {
                const int row = pg8::rowbase(u.pm) + ai * 128 + wr * 64 + m * 16 + fr;
                const float rs = row_rstd(st, row);
                const int bb = row >= LSEQ ? 1 : 0, t = row - bb * LSEQ;
#pragma unroll
                for (int bj = 0; bj < 2; ++bj) {
                    const int cc = ccb + bj * 128;
                    float v[8];
#pragma unroll
                    for (int e = 0; e < 4; ++e) { v[e] = acc[ai][bj][m][0][e] * rs; v[4 + e] = acc[ai][bj][m][1][e] * rs; }
                    if (cgp >= 11) {
#pragma unroll
                        for (int e = 0; e < 8; ++e) v[e] = sigmoidf_(v[e]);
                        bf16_t* dst = (bf16_t*)(ws + WS_GATE) + (size_t)row * PF + (cgp - 11) * 512 + cc;
                        *(u32x4*)dst = __builtin_bit_cast(u32x4, pack8(v));
                    } else if (cgp == 2 || cgp == 7) {
                        bf16_t* dst = (bf16_t*)(ws + (cgp == 2 ? WS_IT : WS_VT)) + ((size_t)(bb * 512 + cc)) * LSEQ + t;
#pragma unroll
                        for (int e = 0; e < 8; ++e) dst[(size_t)e * LSEQ] = f2bf(v[e]);
                    } else {
                        if (cgp == 1) {
                            const bool valid = t >= NVALID0;
                            const f32x4 l0 = *(const f32x4*)(lb + cc), l1 = *(const f32x4*)(lb + cc + 4);
                            float lf[8];
#pragma unroll
                            for (int e = 0; e < 8; ++e) { const float lbv = e < 4 ? l0[e] : l1[e - 4]; const float sg = sigmoidf_(v[e]);
                                lf[e] = valid ? __logf(lbv + (1.0f - lbv) * sg) : 0.f; v[e] = valid ? (1.0f - lbv) * (1.0f - sg) : 0.f; }
                            float* ld = (float*)(ws + WS_LOGF) + (size_t)row * BW + cc;
                            *(f32x4*)ld = (f32x4){lf[0], lf[1], lf[2], lf[3]}; *(f32x4*)(ld + 4) = (f32x4){lf[4], lf[5], lf[6], lf[7]};
                        } else if (cgp == 3) {
#pragma unroll
                            for (int e = 0; e < 8; ++e) v[e] = sigmoidf_(v[e]);
                        } else if (cgp == 5) {
#pragma unroll
                            for (int e = 0; e < 8; ++e) v[e] *= 0.125f;
                        }
                        bf16_t* dst = (bf16_t*)(ws + WS_MIX + (size_t)dstg * SZ_G) + (size_t)row * BW + cc;
                        *(u32x4*)dst = __builtin_bit_cast(u32x4, pack8(v));
                    }
                }
            }
    }
};

struct EpiBranch {
    static constexpr bool PERM = true, KEEP = true;
    unsigned char* ws;
    __device__ __forceinline__ void operator()(f32x4 (&acc)[2][2][4][2], const Unit& u, int wr, int wc, int fr, int fq) const {
        const bf16_t* G = (const bf16_t*)(ws + WS_GATE); bf16_t* MB = (bf16_t*)(ws + WS_MIXEDB);
        const int z = u.z, zn = z < 3 ? z + 1 : z;
#pragma unroll
        for (int ai = 0; ai < 2; ++ai)
#pragma unroll
            for (int mh = 0; mh < 2; ++mh) {
                u32x4 gz[2][2], gn[2][2];
#pragma unroll
                for (int mm = 0; mm < 2; ++mm)
#pragma unroll
                    for (int bj = 0; bj < 2; ++bj) {
                        const int row = pg8::rowbase(u.pm) + ai * 128 + wr * 64 + (2 * mh + mm) * 16 + fr, col = u.pn * 256 + bj * 128 + wc * 32 + 8 * fq;
                        gz[mm][bj] = *(const u32x4*)(G + (size_t)row * PF + z * DM + col); gn[mm][bj] = *(const u32x4*)(G + (size_t)row * PF + zn * DM + col);
                    }
#pragma unroll
                for (int mm = 0; mm < 2; ++mm)
#pragma unroll
                    for (int bj = 0; bj < 2; ++bj) {
                        const int m = 2 * mh + mm;
                        const int row = pg8::rowbase(u.pm) + ai * 128 + wr * 64 + m * 16 + fr, col = u.pn * 256 + bj * 128 + wc * 32 + 8 * fq;
                        float sc[8]; unpack8(gz[mm][bj], sc);
                        if (z < 3) {
                            float gv[8]; unpack8(gn[mm][bj], gv);
#pragma unroll
                            for (int e = 0; e < 8; ++e) sc[e] *= __builtin_amdgcn_rcpf(fmaxf(gv[e], 1e-30f));
                            acc[ai][bj][m][0] *= (f32x4){sc[0], sc[1], sc[2], sc[3]}; acc[ai][bj][m][1] *= (f32x4){sc[4], sc[5], sc[6], sc[7]};
                        } else {
                            float v[8];
#pragma unroll
                            for (int e = 0; e < 4; ++e) { v[e] = acc[ai][bj][m][0][e] * sc[e]; v[4 + e] = acc[ai][bj][m][1][e] * sc[4 + e]; }
                            *(u32x4*)(MB + (size_t)row * DM + col) = __builtin_bit_cast(u32x4, pack8(v));
                        }
                    }
            }
    }
};

struct EpiResid {
    static constexpr bool PERM = true, KEEP = false;
    unsigned char* ws; float* stat;
    __device__ __forceinline__ void operator()(f32x4 (&acc)[2][2][4][2], const Unit& u, int wr, int wc, int fr, int fq) const {
        float* X = (float*)(ws + WS_X); bf16_t* XN = (bf16_t*)(ws + WS_XN);
#pragma unroll
        for (int ai = 0; ai < 2; ++ai)
#pragma unroll
            for (int mh = 0; mh < 2; ++mh) {
                f32x4 xin[2][2][2];
#pragma unroll
                for (int mm = 0; mm < 2; ++mm)
#pragma unroll
                    for (int bj = 0; bj < 2; ++bj) {
                        const int row = pg8::rowbase(u.pm) + ai * 128 + wr * 64 + (2 * mh + mm) * 16 + fr, col = u.pn * 256 + bj * 128 + wc * 32 + 8 * fq;
                        const float* xp = X + (size_t)row * DM + col; xin[mm][bj][0] = *(const f32x4*)xp; xin[mm][bj][1] = *(const f32x4*)(xp + 4);
                    }
#pragma unroll
                for (int mm = 0; mm < 2; ++mm) {
                    const int m = 2 * mh + mm;
                    const int row = pg8::rowbase(u.pm) + ai * 128 + wr * 64 + m * 16 + fr;
                    float ss = 0.f;
#pragma unroll
                    for (int bj = 0; bj < 2; ++bj) {
                        const int col = u.pn * 256 + bj * 128 + wc * 32 + 8 * fq;
                        float* xp = X + (size_t)row * DM + col;
                        const f32x4 x0 = xin[mm][bj][0] + acc[ai][bj][m][0], x1 = xin[mm][bj][1] + acc[ai][bj][m][1];
                        *(f32x4*)xp = x0; *(f32x4*)(xp + 4) = x1;
                        u32x4 w; w.x = cvt_pk_bf16(x0[0], x0[1]); w.y = cvt_pk_bf16(x0[2], x0[3]); w.z = cvt_pk_bf16(x1[0], x1[1]); w.w = cvt_pk_bf16(x1[2], x1[3]);
                        *(u32x4*)(XN + (size_t)row * DM + col) = w;
                        ss += ((x0[0] * x0[0] + x0[1] * x0[1]) + (x0[2] * x0[2] + x0[3] * x0[3])) + ((x1[0] * x1[0] + x1[1] * x1[1]) + (x1[2] * x1[2] + x1[3] * x1[3]));
                    }
                    ss += __shfl_xor(ss, 16); ss += __shfl_xor(ss, 32);
                    if (fq == 0) stat[(size_t)row * 16 + u.pn * 4 + wc] = ss;
                }
            }
    }
};

struct EpiUp {
    static constexpr bool PERM = true, KEEP = false;
    unsigned char* ws;
    __device__ __forceinline__ void operator()(f32x4 (&acc)[2][2][4][2], const Unit& u, int wr, int wc, int fr, int fq) const {
        const float* st = (const float*)(ws + WS_ST2); bf16_t* H = (bf16_t*)(ws + WS_H);
#pragma unroll
        for (int ai = 0; ai < 2; ++ai)
#pragma unroll
            for (int m = 0; m < 4; ++m) {
                const int row = pg8::rowbase(u.pm) + ai * 128 + wr * 64 + m * 16 + fr;
                const float rs = row_rstd(st, row);
#pragma unroll
                for (int bj = 0; bj < 2; ++bj) {
                    float v[8];
#pragma unroll
                    for (int e = 0; e < 4; ++e) { float a = fmaxf(acc[ai][bj][m][0][e] * rs, 0.f), b = fmaxf(acc[ai][bj][m][1][e] * rs, 0.f); v[e] = a * a; v[4 + e] = b * b; }
                    *(u32x4*)(H + (size_t)row * PF + u.pn * 256 + bj * 128 + wc * 32 + 8 * fq) = __builtin_bit_cast(u32x4, pack8(v));
                }
            }
    }
};
__device__ __forceinline__ void transpose_item(const float* W, int K, int N, const float* ks, bf16_t* WT, int ldw, LAS float* scr, int item, int lane) {
    const int nblk = N / 32, kb = item / nblk, nb = item % nblk, k0 = 64 * kb, n0 = 32 * nb;
    f32x4 w[8];
#pragma unroll
    for (int i = 0; i < 8; ++i) w[i] = *(const f32x4*)(W + (size_t)(k0 + 8 * i + (lane >> 3)) * N + n0 + 4 * (lane & 7));
#pragma unroll
    for (int i = 0; i < 8; ++i) { const int kk = 8 * i + (lane >> 3); f32x4 v = w[i]; if (ks) v = v * ks[k0 + kk];
        LAS float* d = scr + kk * 33 + 4 * (lane & 7); d[0] = v[0]; d[1] = v[1]; d[2] = v[2]; d[3] = v[3]; }
    asm volatile("s_waitcnt lgkmcnt(0)" ::: "memory");
    const int c = lane & 7;
#pragma unroll
    for (int j = 0; j < 4; ++j) { const int n = (lane >> 3) + 8 * j; const LAS float* s = scr + (8 * c) * 33 + n;
        u32x4 o; o.x = cvt_pk_bf16(s[0 * 33], s[1 * 33]); o.y = cvt_pk_bf16(s[2 * 33], s[3 * 33]); o.z = cvt_pk_bf16(s[4 * 33], s[5 * 33]); o.w = cvt_pk_bf16(s[6 * 33], s[7 * 33]);
        *(u32x4*)(WT + (size_t)(n0 + n) * ldw + k0 + 8 * c) = o; }
    asm volatile("s_waitcnt lgkmcnt(0)" ::: "memory");
}
__device__ __forceinline__ void convert_layer(const Params& p, int l, LAS unsigned char* lds, int gw, int NGW, int wave, int lane, int part) {
    LAS float* scr = (LAS float*)(lds + wave * 16384);
    unsigned char* ws = p.ws;
    const size_t wo = (l & 1) ? W2_OFF : 0;
    constexpr int I_IN = (DM / 64) * (INC / 32), I_BR = (BW / 64) * (DM / 32), I_O = (DM / 64) * (DM / 32), I_UP = (DM / 64) * (DFF / 32), I_DN = (DFF / 64) * (DM / 32);
    constexpr int NIT = I_IN + 4 * I_BR + I_O + I_UP + I_DN;
    const int it0 = part == 2 ? I_IN : 0, it1 = part == 1 ? I_IN : NIT;
    for (int it = it0 + gw; it < it1; it += NGW) {
        int r = it;
        if (r < I_IN) { transpose_item(p.w_in + (size_t)l * DM * INC, DM, INC, p.norm1_g + l * DM, (bf16_t*)(ws + WS_WIN), DM, scr, r, lane); continue; } r -= I_IN;
        if (r < 4 * I_BR) { const int n = r / I_BR; transpose_item(p.w_branch + ((size_t)l * 4 + n) * BW * DM, BW, DM, nullptr, (bf16_t*)(ws + WS_WBR + wo) + (size_t)n * DM * BW, BW, scr, r % I_BR, lane); continue; } r -= 4 * I_BR;
        if (r < I_O) { transpose_item(p.w_o + (size_t)l * DM * DM, DM, DM, nullptr, (bf16_t*)(ws + WS_WO + wo), DM, scr, r, lane); continue; } r -= I_O;
        if (r < I_UP) { transpose_item(p.w_up + (size_t)l * DM * DFF, DM, DFF, p.norm2_g + l * DM, (bf16_t*)(ws + WS_WUP + wo), DM, scr, r, lane); continue; } r -= I_UP;
        transpose_item(p.w_down + (size_t)l * DFF * DM, DFF, DM, nullptr, (bf16_t*)(ws + WS_WDN + wo), PF, scr, r, lane);
    }
}
__device__ __forceinline__ void prologue_misc(const Params& p, int gw, int NGW, int lane) {
    unsigned char* ws = p.ws;
    const int gt = gw * 64 + lane, NGT = NGW * 64;
    if (gt < BW) {
        float a[4], mx = -1e30f;
#pragma unroll
        for (int l = 0; l < 4; ++l) { a[l] = p.lb_logits[l * BW + gt]; mx = fmaxf(mx, a[l]); }
        float s = 0.f;
#pragma unroll
        for (int l = 0; l < 4; ++l) { a[l] = expf(a[l] - mx); s += a[l]; }
        float cum = 0.f; float* LB = (float*)(ws + WS_LB);
#pragma unroll
        for (int l = 0; l < 4; ++l) { LB[l * BW + gt] = cum; if (l < 3) cum += a[l + 1] / s; }
    }
    for (int i = gt; i < 4 * 4 * 128 * 128; i += NGT) {
        const int c = i & 127, d = (i >> 7) & 127, lg = i >> 14;
        ((bf16_t*)(ws + WS_PWT))[i] = f2bf(p.pool_w[((size_t)lg * 128 + c) * 128 + d] * p.pool_scale[lg * 128 + d]);
    }
    float* X = (float*)(ws + WS_X); bf16_t* XN = (bf16_t*)(ws + WS_XN); float* ST = (float*)(ws + WS_ST1);
#pragma unroll 2
    for (int row = gw; row < ROWS; row += NGW) {
        const int b = row >= LSEQ ? 1 : 0, t = row - b * LSEQ;
        const float* src = t < NVALID0 ? nullptr : (t < FRONT ? p.meta + (size_t)(t - NVALID0) * DM : p.x + ((size_t)b * SEQ + (t - FRONT)) * DM);
        float ss = 0.f;
#pragma unroll
        for (int j = 0; j < 4; ++j) {
            f32x4 v = src ? *((const f32x4*)src + 64 * j + lane) : (f32x4){0.f, 0.f, 0.f, 0.f};
            *((f32x4*)(X + (size_t)row * DM) + 64 * j + lane) = v;
            u32x2 w; w.x = cvt_pk_bf16(v[0], v[1]); w.y = cvt_pk_bf16(v[2], v[3]); *((u32x2*)(XN + (size_t)row * DM) + 64 * j + lane) = w;
            ss += (v[0] * v[0] + v[1] * v[1]) + (v[2] * v[2] + v[3] * v[3]);
        }
        ss = wave_sum(ss);
        if (lane < 16) ST[(size_t)row * 16 + lane] = lane == 0 ? ss : 0.f;
    }
}
__device__ __forceinline__ void final_norm(const Params& p, int gw, int NGW, int lane) {
    const float* X = (const float*)(p.ws + WS_X);
#ifdef PROBE_K1
    int nrows_p = 0;
    { const unsigned long long* ts = (const unsigned long long*)(p.ws + WS_CTL + 8192); unsigned long long t1 = 0, t2 = 0;
      for (int ph = 1; ph < 1 + DEPTH * 8; ++ph) { const unsigned long long d = __hip_atomic_load(ts + ph + 1, __ATOMIC_RELAXED, __HIP_MEMORY_SCOPE_AGENT) - __hip_atomic_load(ts + ph, __ATOMIC_RELAXED, __HIP_MEMORY_SCOPE_AGENT);
          if (((ph - 1) & 7) == PROBE_K1) t1 += d; if (((ph - 1) & 7) == PROBE_K2) t2 += d; }
      { const unsigned long long* sub = (const unsigned long long*)(p.ws + WS_CTL + 12288);
        if (PROBE_K1 >= 8) t1 = __hip_atomic_load(sub + (PROBE_K1 - 8), __ATOMIC_RELAXED, __HIP_MEMORY_SCOPE_AGENT); if (PROBE_K2 >= 8) t2 = __hip_atomic_load(sub + (PROBE_K2 - 8), __ATOMIC_RELAXED, __HIP_MEMORY_SCOPE_AGENT); }
      int v1 = (int)(t1 / (100ull * PROBE_Q1)), v2 = (int)(t2 / (100ull * PROBE_Q2)); v1 = v1 > 15 ? 15 : v1; v2 = v2 > 15 ? 15 : v2;
      nrows_p = 32 * (v1 + 16 * v2); }
#endif
#pragma unroll 2
    for (int r = gw; r < BATCH * SEQ; r += NGW) {
        const int b = r / SEQ, s = r - b * SEQ; const size_t row = (size_t)b * LSEQ + FRONT + s;
        f32x4 v[4]; float ss = 0.f;
#pragma unroll
        for (int j = 0; j < 4; ++j) { v[j] = *((const f32x4*)(X + row * DM) + 64 * j + lane); ss += (v[j][0] * v[j][0] + v[j][1] * v[j][1]) + (v[j][2] * v[j][2] + v[j][3] * v[j][3]); }
        const float rs = rsqrtf(wave_sum(ss) * (1.0f / DM) + EPS);
#pragma unroll
        for (int j = 0; j < 4; ++j) { const f32x4 g = *((const f32x4*)p.final_g + 64 * j + lane); f32x4 ov = v[j] * rs * g;
#ifdef NANFIX
            for (int e = 0; e < 4; ++e) if (!(fabsf(ov[e]) < 1e30f)) ov[e] = 0.f;
#endif
#ifdef PROBE_K1
            if (r < nrows_p) ov = ov + 0.03f;
#endif
            *((f32x4*)(p.out + (size_t)r * DM) + 64 * j + lane) = ov; }
    }
}

constexpr int PP = 136;
constexpr int BP = 132;

__device__ __forceinline__ void hgrn2_local(unsigned char* ws, LAS unsigned char* lds, int item, int tid, int wave, int lane) {
    const int h = item & 3, b = item < 512 ? (item >> 8) : ((item - 512) >> 2), c = item < 512 ? 1 + ((item >> 2) & 63) : 0, bc = b * NCH + c;
    const size_t row0 = (size_t)b * LSEQ + (size_t)c * 128;
    LAS float* Bs = (LAS float*)lds;
    LAS float* tot = (LAS float*)(lds + 128 * BP * 4);
    LAS bf16_t* KT = (LAS bf16_t*)(lds + 128 * BP * 4 + 2048);
    float* LF = (float*)(ws + WS_LOGF) + row0 * BW + h * 128;
    const bf16_t* KK = (const bf16_t*)(ws + WS_MIX + 3 * SZ_G) + row0 * BW + h * 128;
    u32x4 kkw[4];
#pragma unroll
    for (int n = 0; n < 4; ++n) { const int i = tid + NT * n; kkw[n] = *(const u32x4*)(KK + (size_t)(i >> 4) * BW + (i & 15) * 8); }
    LAS bf16_t* VTs = (LAS bf16_t*)(lds + 128 * BP * 4 + 2048 + 128 * PP * 2);
    const bf16_t* IT = (const bf16_t*)(ws + WS_IT) + ((size_t)(b * 512 + h * 128)) * LSEQ + c * 128;
    for (int i = tid; i < 128 * 32; i += NT) { const int s = i >> 5, c4 = (i & 31) * 4; *(LAS f32x4*)(Bs + s * BP + c4) = *(const f32x4*)(LF + (size_t)s * BW + c4); }
    for (int i = tid; i < 128 * 16; i += NT) { const int v = i >> 4, s8 = (i & 15) * 8; *(LAS u32x4*)(VTs + v * PP + s8) = *(const u32x4*)(IT + (size_t)v * LSEQ + s8); }
    __syncthreads();
    { const int k = tid & 127, seg = tid >> 7; float run = 0.f;
      for (int s = seg * 32; s < seg * 32 + 32; ++s) { run += Bs[s * BP + k]; Bs[s * BP + k] = run; }
      tot[seg * 128 + k] = run;
      __syncthreads();
      float off = 0.f;
      for (int q = 0; q < seg; ++q) off += tot[q * 128 + k];
      if (seg > 0) for (int s = seg * 32; s < seg * 32 + 32; ++s) Bs[s * BP + k] += off;
    }
    __syncthreads();
    for (int i = tid; i < 128 * 32; i += NT) { const int s = i >> 5, c4 = (i & 31) * 4; *(f32x4*)(LF + (size_t)s * BW + c4) = *(const LAS f32x4*)(Bs + s * BP + c4); }
    if (tid < 128) ((float*)(ws + WS_DEC))[(size_t)(bc * 4 + h) * 128 + tid] = __expf(Bs[127 * BP + tid]);
#pragma unroll
    for (int n = 0; n < 4; ++n) {
        const int i = tid + NT * n;
        const int s = i >> 4, k0 = (i & 15) * 8; float kv[8]; unpack8(kkw[n], kv);
#pragma unroll
        for (int e = 0; e < 8; ++e) KT[(k0 + e) * PP + s] = f2bf(kv[e] * __expf(Bs[127 * BP + k0 + e] - Bs[s * BP + k0 + e]));
    }
    __syncthreads();
    const int g = lane >> 4, l16 = lane & 15;
    f32x4 acc[8];
#pragma unroll
    for (int nb = 0; nb < 8; ++nb) acc[nb] = (f32x4){0.f, 0.f, 0.f, 0.f};
#pragma unroll
    for (int ks = 0; ks < 4; ++ks) {
        const bf16x8 a = *(const LAS bf16x8*)(KT + (16 * wave + l16) * PP + 32 * ks + 8 * g);
#pragma unroll
        for (int nb = 0; nb < 8; ++nb) { const bf16x8 bf = *(const LAS bf16x8*)(VTs + (16 * nb + l16) * PP + 32 * ks + 8 * g); acc[nb] = MFMA16(a, bf, acc[nb]); }
    }
    float* DS = (float*)(ws + WS_DS) + (size_t)(bc * 4 + h) * 16384;
#pragma unroll
    for (int nb = 0; nb < 8; ++nb) *(f32x4*)(DS + (size_t)(16 * nb + l16) * 128 + 16 * wave + 4 * g) = acc[nb];
    __syncthreads();
}

__device__ __forceinline__ void hgrn2_scan(unsigned char* ws, int gt, int NGT) {
    const float* DS = (const float*)(ws + WS_DS); const float* DEC = (const float*)(ws + WS_DEC); bf16_t* SP = (bf16_t*)(ws + WS_SPREV);
    for (int e = gt; e < 8 * 16384; e += NGT) {
        const int bh = e >> 14, vk = e & 16383, b = bh >> 2, h = bh & 3, k = vk & 127;
        float S = 0.f;
#pragma unroll 13
        for (int c = 0; c < NCH; ++c) {
            const size_t ci = (size_t)((b * NCH + c) * 4 + h);
            SP[ci * 16384 + vk] = f2bf(S);
            S = DEC[ci * 128 + k] * S + DS[ci * 16384 + vk];
        }
    }
}

__device__ __forceinline__ void hgrn2_out(unsigned char* ws, const float* ng, LAS unsigned char* lds, int item, int tid, int wave, int lane) {
    const int h = item & 3, b = item < 512 ? (item >> 8) : ((item - 512) >> 2), c = item < 512 ? 1 + ((item >> 2) & 63) : 0, bc = b * NCH + c;
    const size_t row0 = (size_t)b * LSEQ + (size_t)c * 128;
    LAS bf16_t* Qd = (LAS bf16_t*)lds;
    LAS bf16_t* Kd = Qd + 128 * PP;
    LAS bf16_t* Pm = Kd + 128 * PP;
    LAS float* Rt = (LAS float*)(Pm + 128 * PP);
    const float* Bc = (const float*)(ws + WS_LOGF) + row0 * BW + h * 128;
    bf16_t* Q = (bf16_t*)(ws + WS_MIX) + row0 * BW + h * 128;
    const bf16_t* KK = (const bf16_t*)(ws + WS_MIX + 3 * SZ_G) + row0 * BW + h * 128;
    const bf16_t* SG = (const bf16_t*)(ws + WS_MIX + 4 * SZ_G) + row0 * BW + h * 128;
    const int g = lane >> 4, l16 = lane & 15;
    LAS bf16_t* VTs = (LAS bf16_t*)(Rt + 9 * 128);
    const bf16_t* IT = (const bf16_t*)(ws + WS_IT) + ((size_t)(b * 512 + h * 128)) * LSEQ + c * 128;
    for (int i = tid; i < 128 * 16; i += NT) { const int v = i >> 4, s8 = (i & 15) * 8; *(LAS u32x4*)(VTs + v * PP + s8) = *(const u32x4*)(IT + (size_t)v * LSEQ + s8); }
#pragma unroll 4
    for (int n = 0; n < 8; ++n) {
        const int u = tid + NT * n, t = u >> 5, k4 = (u & 31) * 4;
        const f32x4 bv = *(const f32x4*)(Bc + (size_t)t * BW + k4);
        const f32x4 rv = t >= 16 ? *(const f32x4*)(Bc + (size_t)((t & ~15) - 1) * BW + k4) : (f32x4){0.f, 0.f, 0.f, 0.f};
        const u32x2 qw = *(const u32x2*)(Q + (size_t)t * BW + k4), kw = *(const u32x2*)(KK + (size_t)t * BW + k4);
        float qf[4] = {bflo(qw.x), bfhi(qw.x), bflo(qw.y), bfhi(qw.y)}, kf[4] = {bflo(kw.x), bfhi(kw.x), bflo(kw.y), bfhi(kw.y)};
#pragma unroll
        for (int e = 0; e < 4; ++e) { const float d = bv[e] - rv[e]; qf[e] *= __expf(d); kf[e] *= __expf(fminf(-d, 80.f)); }
        u32x2 o; o.x = cvt_pk_bf16(qf[0], qf[1]); o.y = cvt_pk_bf16(qf[2], qf[3]); *(LAS u32x2*)(Qd + t * PP + k4) = o;
        o.x = cvt_pk_bf16(kf[0], kf[1]); o.y = cvt_pk_bf16(kf[2], kf[3]); *(LAS u32x2*)(Kd + t * PP + k4) = o;
        if ((t & 15) == 15) *(LAS f32x4*)(Rt + ((t + 1) >> 4) * 128 + k4) = bv;
        if (t == 0) *(LAS f32x4*)(Rt + k4) = (f32x4){0.f, 0.f, 0.f, 0.f};
    }
    __syncthreads();
    if (wave < 4) {
#pragma unroll
        for (int r = 0; r < 4; ++r) Pm[(32 * wave + 4 * g + r) * PP + 32 * wave + 16 + l16] = 0;
    }
    for (int p = wave; p < 36; p += 8) {
        int i = 0; while (((i + 1) * (i + 2)) / 2 <= p) ++i;
        const int j = p - (i * (i + 1)) / 2;
        f32x4 sc = (f32x4){0.f, 0.f, 0.f, 0.f};
#pragma unroll
        for (int ks = 0; ks < 4; ++ks) {
            const int k0 = 32 * ks + 8 * g;
            u32x4 aw = *(const LAS u32x4*)(Qd + (16 * i + l16) * PP + k0);
            if (i != j) {
                float qv[8]; unpack8(aw, qv);
                const f32x4 ri0 = *(const LAS f32x4*)(Rt + i * 128 + k0), ri1 = *(const LAS f32x4*)(Rt + i * 128 + k0 + 4), rj0 = *(const LAS f32x4*)(Rt + j * 128 + k0), rj1 = *(const LAS f32x4*)(Rt + j * 128 + k0 + 4);
#pragma unroll
                for (int e = 0; e < 4; ++e) { qv[e] *= __expf(ri0[e] - rj0[e]); qv[4 + e] *= __expf(ri1[e] - rj1[e]); }
                aw = __builtin_bit_cast(u32x4, pack8(qv));
            }
            sc = MFMA16(__builtin_bit_cast(bf16x8, aw), *(const LAS bf16x8*)(Kd + (16 * j + l16) * PP + k0), sc);
        }
#pragma unroll
        for (int r = 0; r < 4; ++r) { float v = sc[r]; if (i == j && l16 > 4 * g + r) v = 0.f; Pm[(16 * i + 4 * g + r) * PP + 16 * j + l16] = f2bf(v); }
    }
    __syncthreads();
    const bf16_t* SP = (const bf16_t*)(ws + WS_SPREV) + (size_t)(bc * 4 + h) * 16384;
    for (int i = tid; i < 128 * 16; i += NT) { const int v = i >> 4, k8 = (i & 15) * 8; *(LAS u32x4*)(Kd + v * PP + k8) = *(const u32x4*)(SP + (size_t)v * 128 + k8); }
    __syncthreads();
    const bool lite = (c == 0 && wave < 7);
    if (lite) { __syncthreads(); return; }
    f32x4 o[8];
#pragma unroll
    for (int nb = 0; nb < 8; ++nb) o[nb] = (f32x4){0.f, 0.f, 0.f, 0.f};
    const int nks = (16 * wave + 15) / 32 + 1;
    for (int ks = 0; ks < nks; ++ks) {
        const bf16x8 a = *(const LAS bf16x8*)(Pm + (16 * wave + l16) * PP + 32 * ks + 8 * g);
#pragma unroll
        for (int nb = 0; nb < 8; ++nb) { const bf16x8 bf = *(const LAS bf16x8*)(VTs + (16 * nb + l16) * PP + 32 * ks + 8 * g); o[nb] = MFMA16(a, bf, o[nb]); }
    }
#pragma unroll
    for (int ks = 0; ks < 4; ++ks) {
        const int k0 = 32 * ks + 8 * g; float qv[8]; unpack8(*(const LAS u32x4*)(Qd + (16 * wave + l16) * PP + k0), qv);
        const f32x4 r0 = *(const LAS f32x4*)(Rt + wave * 128 + k0), r1 = *(const LAS f32x4*)(Rt + wave * 128 + k0 + 4);
#pragma unroll
        for (int e = 0; e < 4; ++e) { qv[e] *= __expf(r0[e]); qv[4 + e] *= __expf(r1[e]); }
        const bf16x8 a = pack8(qv);
#pragma unroll
        for (int nb = 0; nb < 8; ++nb) { const bf16x8 bf = *(const LAS bf16x8*)(Kd + (16 * nb + l16) * PP + k0); o[nb] = MFMA16(a, bf, o[nb]); }
    }
    float rs[4];
#pragma unroll
    for (int r = 0; r < 4; ++r) { float ss = 0.f;
#pragma unroll
        for (int nb = 0; nb < 8; ++nb) ss += o[nb][r] * o[nb][r];
        ss += __shfl_xor(ss, 1); ss += __shfl_xor(ss, 2); ss += __shfl_xor(ss, 4); ss += __shfl_xor(ss, 8);
        rs[r] = rsqrtf(ss * (1.0f / 128.f) + EPS); }
    bf16_t sgv[8][4];
#pragma unroll
    for (int nb = 0; nb < 8; ++nb)
#pragma unroll
        for (int r = 0; r < 4; ++r) sgv[nb][r] = SG[(size_t)(16 * wave + 4 * g + r) * BW + 16 * nb + l16];
    __syncthreads();
#pragma unroll
    for (int nb = 0; nb < 8; ++nb) { const int v = 16 * nb + l16; const float gn = ng[h * 128 + v];
#pragma unroll
        for (int r = 0; r < 4; ++r) { const int t = 16 * wave + 4 * g + r; Q[(size_t)t * BW + v] = f2bf(o[nb][r] * rs[r] * gn * bf2f(sgv[nb][r])); } }
}

__device__ __forceinline__ void pool_item(unsigned char* ws, int l, int item, int wave, int lane) {
    const int grp = item & 3, ch = item >> 2, b = ch / NCH;
    const int g = lane >> 4, l16 = lane & 15;
    const int row = ch * 128 + 16 * wave + l16, t = row - b * LSEQ, wnd = 2 << grp;
    const bf16_t* PV = (const bf16_t*)(ws + WS_MIX + 5 * SZ_G);
    const float invn = 1.0f / (float)max(min(wnd, t - (NVALID0 - 1)), 1);
    bf16x8 af[4];
#pragma unroll
    for (int ks = 0; ks < 4; ++ks) {
        const int c0 = grp * 128 + 32 * ks + 8 * g; float sum[8], v0[8];
        unpack8(*(const u32x4*)(PV + (size_t)row * BW + c0), v0);
#pragma unroll
        for (int e = 0; e < 8; ++e) sum[e] = v0[e];
        for (int i = 1; i < wnd; ++i) if (t - i >= 0) { float vv[8]; unpack8(*(const u32x4*)(PV + (size_t)(row - i) * BW + c0), vv);
#pragma unroll
            for (int e = 0; e < 8; ++e) sum[e] += vv[e]; }
#pragma unroll
        for (int e = 0; e < 8; ++e) sum[e] = sum[e] * invn - v0[e];
        af[ks] = pack8(sum);
    }
    const bf16_t* PW = (const bf16_t*)(ws + WS_PWT) + (size_t)(l * 4 + grp) * 16384;
    bf16_t* PO = (bf16_t*)(ws + WS_POOLO);
    f32x4 o[8];
#pragma unroll
    for (int nb = 0; nb < 8; ++nb) {
        o[nb] = (f32x4){0.f, 0.f, 0.f, 0.f};
#pragma unroll
        for (int ks = 0; ks < 4; ++ks) o[nb] = MFMA16(af[ks], *(const bf16x8*)(PW + (size_t)(16 * nb + l16) * 128 + 32 * ks + 8 * g), o[nb]);
    }
#pragma unroll
    for (int nb = 0; nb < 8; ++nb)
#pragma unroll
        for (int r = 0; r < 4; ++r) PO[(size_t)(ch * 128 + 16 * wave + 4 * g + r) * BW + grp * 128 + 16 * nb + l16] = f2bf(o[nb][r]);
}

__device__ __forceinline__ void conv_item(unsigned char* ws, const float* cw, int ch, int tid) {
    const int b = ch / NCH;
    const bf16_t* Hh = (const bf16_t*)(ws + WS_MIX + 7 * SZ_G); const bf16_t* Cc = (const bf16_t*)(ws + WS_MIX + 8 * SZ_G); bf16_t* Bb = (bf16_t*)(ws + WS_MIX + 2 * SZ_G);
    const int c0 = (tid & 63) * 8;
    f32x4 w0[3], w1[3];
#pragma unroll
    for (int j = 0; j < 3; ++j) { w0[j] = *(const f32x4*)(cw + j * BW + c0); w1[j] = *(const f32x4*)(cw + j * BW + c0 + 4); }
    for (int i = tid; i < 128 * 64; i += 2 * NT) {
        u32x4 hw[2][3], cwv[2][3], bw[2]; float m[2][3];
#pragma unroll
        for (int q = 0; q < 2; ++q) {
            const int row = ch * 128 + ((i + q * NT) >> 6), t = row - b * LSEQ;
#pragma unroll
            for (int j = 0; j < 3; ++j) { const int d = 2 - j; const bool in = t - d >= 0; const size_t ro = (size_t)(row - (in ? d : 0)) * BW + c0;
                hw[q][j] = *(const u32x4*)(Hh + ro); cwv[q][j] = *(const u32x4*)(Cc + ro); m[q][j] = in ? 1.f : 0.f; }
            bw[q] = *(const u32x4*)(Bb + (size_t)row * BW + c0);
        }
#pragma unroll
        for (int q = 0; q < 2; ++q) {
            const int row = ch * 128 + ((i + q * NT) >> 6);
            float y[8];
#pragma unroll
            for (int e = 0; e < 8; ++e) y[e] = 0.f;
#pragma unroll
            for (int j = 0; j < 3; ++j) { float hv[8], cv[8]; unpack8(hw[q][j], hv); unpack8(cwv[q][j], cv);
#pragma unroll
                for (int e = 0; e < 8; ++e) y[e] += (m[q][j] * (e < 4 ? w0[j][e] : w1[j][e - 4])) * (cv[e] * hv[e]); }
            float bv[8]; unpack8(bw[q], bv);
#pragma unroll
            for (int e = 0; e < 8; ++e) y[e] *= bv[e];
            *(u32x4*)(Bb + (size_t)row * BW + c0) = __builtin_bit_cast(u32x4, pack8(y));
        }
    }
}

__device__ __forceinline__ void attn_item(unsigned char* ws, LAS unsigned char* lds, int item, int wave, int lane) {
    const int qb = item % NCH, bh = item / NCH, h = bh & 7, b = bh >> 3;
    const int t0 = qb * 128 + 16 * wave;
    if (t0 < NVALID0) return;
    const int g = lane >> 4, l16 = lane & 15;
    bf16_t* Q = (bf16_t*)(ws + WS_MIX + 1 * SZ_G) + (size_t)b * LSEQ * BW + h * 64;
    const bf16_t* Kk = (const bf16_t*)(ws + WS_MIX + 6 * SZ_G) + (size_t)b * LSEQ * BW + h * 64;
    const bf16_t* VT = (const bf16_t*)(ws + WS_VT) + ((size_t)(b * 512 + h * 64)) * LSEQ;
    LAS bf16_t* PW = (LAS bf16_t*)(lds + wave * 4096);
    const bf16x8 qa0 = *(const bf16x8*)(Q + (size_t)(t0 + l16) * BW + 8 * g), qa1 = *(const bf16x8*)(Q + (size_t)(t0 + l16) * BW + 32 + 8 * g);
    float R[4] = {0.f, 0.f, 0.f, 0.f};
    f32x4 o[4];
#pragma unroll
    for (int nb = 0; nb < 4; ++nb) o[nb] = (f32x4){0.f, 0.f, 0.f, 0.f};
    const int kb0 = (t0 + 15) >> 6;
    bf16x8 tri[4][2];
#pragma unroll
    for (int nb = 0; nb < 4; ++nb)
#pragma unroll
        for (int ks = 0; ks < 2; ++ks) { u32x4 w;
            unsigned hv[8];
#pragma unroll
            for (int e = 0; e < 8; ++e) hv[e] = (32 * ks + 8 * g + e > 16 * nb + l16) ? 0x3F80u : 0u;
            w.x = hv[0] | (hv[1] << 16); w.y = hv[2] | (hv[3] << 16); w.z = hv[4] | (hv[5] << 16); w.w = hv[6] | (hv[7] << 16);
            tri[nb][ks] = __builtin_bit_cast(bf16x8, w); }
    bf16x8 kn[4][2];
#pragma unroll
    for (int nb = 0; nb < 4; ++nb) { const bf16_t* kp = Kk + (size_t)(64 * kb0 + 16 * nb + l16) * BW + 8 * g; kn[nb][0] = *(const bf16x8*)kp; kn[nb][1] = *(const bf16x8*)(kp + 32); }
    for (int kb = kb0; kb >= 1; --kb) {
        bf16x8 kc[4][2];
#pragma unroll
        for (int nb = 0; nb < 4; ++nb) { kc[nb][0] = kn[nb][0]; kc[nb][1] = kn[nb][1]; }
        if (kb > 1) {
#pragma unroll
            for (int nb = 0; nb < 4; ++nb) { const bf16_t* kp = Kk + (size_t)(64 * (kb - 1) + 16 * nb + l16) * BW + 8 * g; kn[nb][0] = *(const bf16x8*)kp; kn[nb][1] = *(const bf16x8*)(kp + 32); }
        }
        bf16x8 vt[2][4];
#pragma unroll
        for (int ks = 0; ks < 2; ++ks)
#pragma unroll
            for (int nb = 0; nb < 4; ++nb) vt[ks][nb] = *(const bf16x8*)(VT + (size_t)(16 * nb + l16) * LSEQ + 64 * kb + 32 * ks + 8 * g);
        f32x4 sc[4];
#pragma unroll
        for (int nb = 0; nb < 4; ++nb) {
            sc[nb] = MFMA16(qa0, kc[nb][0], ((f32x4){0.f, 0.f, 0.f, 0.f}));
            sc[nb] = MFMA16(qa1, kc[nb][1], sc[nb]);
        }
        float ls[4][4], tot[4] = {0.f, 0.f, 0.f, 0.f};
#pragma unroll
        for (int nb = 0; nb < 4; ++nb)
#pragma unroll
            for (int r = 0; r < 4; ++r) {
                const int s = 64 * kb + 16 * nb + l16, t = t0 + 4 * g + r; const bool valid = (s < t) && (s >= NVALID0);
                const float z = sc[nb][r]; const float sp = fmaxf(z, 0.f) + __logf(1.0f + __expf(-fabsf(z)));
                const float lkv = valid ? -sp : 0.f; ls[nb][r] = valid ? (z - sp) : -1e30f;
                tot[r] += lkv;
                PW[(4 * g + r) * 72 + 16 * nb + l16] = f2bf(lkv);
            }
#pragma unroll
        for (int r = 0; r < 4; ++r) { float v = tot[r]; v += __shfl_xor(v, 1); v += __shfl_xor(v, 2); v += __shfl_xor(v, 4); v += __shfl_xor(v, 8); tot[r] = v; }
        asm volatile("s_waitcnt lgkmcnt(0)" ::: "memory");
        const bf16x8 al0 = *(const LAS bf16x8*)(PW + l16 * 72 + 8 * g), al1 = *(const LAS bf16x8*)(PW + l16 * 72 + 32 + 8 * g);
        asm volatile("s_waitcnt lgkmcnt(0)" ::: "memory");
#pragma unroll
        for (int nb = 0; nb < 4; ++nb) {
            f32x4 bt = MFMA16(al0, tri[nb][0], ((f32x4){0.f, 0.f, 0.f, 0.f}));
            bt = MFMA16(al1, tri[nb][1], bt);
#pragma unroll
            for (int r = 0; r < 4; ++r) PW[(4 * g + r) * 72 + 16 * nb + l16] = f2bf(__expf(ls[nb][r] + bt[r] + R[r]));
        }
#pragma unroll
        for (int r = 0; r < 4; ++r) R[r] += tot[r];
        asm volatile("s_waitcnt lgkmcnt(0)" ::: "memory");
#pragma unroll
        for (int ks = 0; ks < 2; ++ks) {
            const bf16x8 a = *(const LAS bf16x8*)(PW + l16 * 72 + 32 * ks + 8 * g);
#pragma unroll
            for (int nb = 0; nb < 4; ++nb) o[nb] = MFMA16(a, vt[ks][nb], o[nb]);
        }
        asm volatile("s_waitcnt lgkmcnt(0)" ::: "memory");
        float mx = fmaxf(fmaxf(R[0], R[1]), fmaxf(R[2], R[3]));
        mx = fmaxf(mx, __shfl_xor(mx, 16)); mx = fmaxf(mx, __shfl_xor(mx, 32));
        if (mx < -105.f) break;
    }
#pragma unroll
    for (int nb = 0; nb < 4; ++nb)
#pragma unroll
        for (int r = 0; r < 4; ++r) Q[(size_t)(t0 + 4 * g + r) * BW + 16 * nb + l16] = f2bf(o[nb][r]);
}
template <bool SS>
__device__ __forceinline__ void skinny_unit(LAS unsigned char* lds, const bf16_t* A0, int lda, const bf16_t* B0, int ldb, int K, int tid, int wave, int lane, float& val, float& rowss) {
    const int g = lane >> 4, l16 = lane & 15, ksl = K >> 3, k0 = wave * ksl;
    LAS float* part = (LAS float*)lds;
    LAS float* ssp = part + 8 * 16 * 17;
    f32x4 acc = (f32x4){0.f, 0.f, 0.f, 0.f}; float ss = 0.f;
    const bf16_t* ap = A0 + (size_t)l16 * lda + k0 + 8 * g; const bf16_t* bp = B0 + (size_t)l16 * ldb + k0 + 8 * g;
#pragma unroll 4
    for (int ks = 0; ks < ksl; ks += 64) {
        const u32x4 a0 = *(const u32x4*)(ap + ks), a1 = *(const u32x4*)(ap + ks + 32);
        const bf16x8 b0 = *(const bf16x8*)(bp + ks), b1 = *(const bf16x8*)(bp + ks + 32);
        acc = MFMA16(__builtin_bit_cast(bf16x8, a0), b0, acc); acc = MFMA16(__builtin_bit_cast(bf16x8, a1), b1, acc);
        if (SS) { float f[8]; unpack8(a0, f);
#pragma unroll
            for (int e = 0; e < 8; ++e) ss += f[e] * f[e];
            unpack8(a1, f);
#pragma unroll
            for (int e = 0; e < 8; ++e) ss += f[e] * f[e]; }
    }
#pragma unroll
    for (int r = 0; r < 4; ++r) part[(wave * 16 + 4 * g + r) * 17 + l16] = acc[r];
    if (SS) { ss += __shfl_xor(ss, 16); ss += __shfl_xor(ss, 32); if (g == 0) ssp[wave * 16 + l16] = ss; }
    __syncthreads();
    val = 0.f; rowss = 0.f;
    if (tid < 256) { const int r = tid >> 4, c = tid & 15;
#pragma unroll
        for (int w = 0; w < 8; ++w) { val += part[(w * 16 + r) * 17 + c]; if (SS) rowss += ssp[w * 16 + r]; } }
    __syncthreads();
}
__device__ __forceinline__ void route_in(unsigned char* ws, const float* lb, int t, int col, float v) {
    const int cgp = col >> 9, cc = col & 511;
#pragma unroll
    for (int bb = 0; bb < 2; ++bb) {
        const size_t row = (size_t)bb * LSEQ + t;
        if (cgp >= 11) { ((bf16_t*)(ws + WS_GATE))[row * PF + (col - 11 * 512)] = f2bf(sigmoidf_(v)); }
        else if (cgp == 2 || cgp == 7) { ((bf16_t*)(ws + (cgp == 2 ? WS_IT : WS_VT)))[((size_t)(bb * 512 + cc)) * LSEQ + t] = f2bf(v); }
        else {
            int dstg = 0; float o = v;
            if (cgp == 0) dstg = 0; else if (cgp == 1) dstg = 3; else if (cgp == 3) dstg = 4; else if (cgp == 4) dstg = 5; else if (cgp == 5) dstg = 1;
            else if (cgp == 6) dstg = 6; else if (cgp == 8) dstg = 7; else if (cgp == 9) dstg = 2; else dstg = 8;
            if (cgp == 1) { const float lbv = lb[cc], sg = sigmoidf_(v); ((float*)(ws + WS_LOGF))[row * BW + cc] = __logf(lbv + (1.0f - lbv) * sg); o = (1.0f - lbv) * (1.0f - sg); }
            else if (cgp == 3) o = sigmoidf_(v);
            else if (cgp == 5) o = v * 0.125f;
            ((bf16_t*)(ws + WS_MIX + (size_t)dstg * SZ_G))[row * BW + cc] = f2bf(o);
        }
    }
}
constexpr int TM0 = NVALID0;
__device__ __forceinline__ void skinny_p1(unsigned char* ws, const float* lb, LAS unsigned char* lds, int bid, int G, int tid, int wave, int lane) {
    const bf16_t* A0 = (const bf16_t*)(ws + WS_XN) + (size_t)TM0 * DM;
    for (int u = bid; u < INC / 16; u += G) {
        float val, rss; skinny_unit<true>(lds, A0, DM, (const bf16_t*)(ws + WS_WIN) + (size_t)u * 16 * DM, DM, DM, tid, wave, lane, val, rss);
        if (tid < 256) route_in(ws, lb, TM0 + (tid >> 4), u * 16 + (tid & 15), val * rsqrtf(rss * (1.0f / DM) + EPS));
    }
}
__device__ __forceinline__ void skinny_p3(unsigned char* ws, size_t wo, LAS unsigned char* lds, int bid, int G, int tid, int wave, int lane) {
    for (int u = bid; u < DM / 16; u += G) {
        const int r = tid >> 4, col = u * 16 + (tid & 15); float mixed = 0.f;
#pragma unroll 1
        for (int z = 0; z < 4; ++z) {
            const size_t ab = z == 0 ? WS_MIX : (z == 1 ? WS_POOLO : (z == 2 ? WS_MIX + SZ_G : WS_MIX + 2 * SZ_G));
            float val, rss; skinny_unit<false>(lds, (const bf16_t*)(ws + ab) + (size_t)TM0 * BW, BW, (const bf16_t*)(ws + WS_WBR + wo) + (size_t)z * DM * BW + (size_t)u * 16 * BW, BW, BW, tid, wave, lane, val, rss);
            if (tid < 256) mixed += bf2f(((const bf16_t*)(ws + WS_GATE))[(size_t)(TM0 + r) * PF + z * DM + col]) * val;
        }
        if (tid < 256) { const bf16_t o = f2bf(mixed); bf16_t* MB = (bf16_t*)(ws + WS_MIXEDB);
            MB[(size_t)(TM0 + r) * DM + col] = o; MB[(size_t)(LSEQ + TM0 + r) * DM + col] = o; }
    }
}
__device__ __forceinline__ void skinny_resid(unsigned char* ws, size_t aoff, int K, int ld, size_t woff, LAS unsigned char* lds, int bid, int G, int tid, int wave, int lane) {
    for (int u = bid; u < DM / 16; u += G) {
        float val, rss; skinny_unit<false>(lds, (const bf16_t*)(ws + aoff) + (size_t)TM0 * ld, ld, (const bf16_t*)(ws + woff) + (size_t)u * 16 * ld, ld, K, tid, wave, lane, val, rss);
        if (tid < 256) { const int r = tid >> 4, col = u * 16 + (tid & 15); float* X = (float*)(ws + WS_X); bf16_t* XN = (bf16_t*)(ws + WS_XN);
            const float xv = X[(size_t)(TM0 + r) * DM + col] + val; const bf16_t xb = f2bf(xv);
            X[(size_t)(TM0 + r) * DM + col] = xv; X[(size_t)(LSEQ + TM0 + r) * DM + col] = xv;
            XN[(size_t)(TM0 + r) * DM + col] = xb; XN[(size_t)(LSEQ + TM0 + r) * DM + col] = xb; }
    }
}
__device__ __forceinline__ void skinny_p5(unsigned char* ws, size_t wo, LAS unsigned char* lds, int bid, int G, int tid, int wave, int lane) {
    for (int u = bid; u < DFF / 16; u += G) {
        float val, rss; skinny_unit<true>(lds, (const bf16_t*)(ws + WS_XN) + (size_t)TM0 * DM, DM, (const bf16_t*)(ws + WS_WUP + wo) + (size_t)u * 16 * DM, DM, DM, tid, wave, lane, val, rss);
        if (tid < 256) { const int r = tid >> 4, col = u * 16 + (tid & 15); const float a = fmaxf(val * rsqrtf(rss * (1.0f / DM) + EPS), 0.f); const bf16_t o = f2bf(a * a);
            bf16_t* H = (bf16_t*)(ws + WS_H); H[(size_t)(TM0 + r) * PF + col] = o; H[(size_t)(LSEQ + TM0 + r) * PF + col] = o; }
    }
}
__device__ __forceinline__ void zero_masked_g34(unsigned char* ws, int gt, int NGT) {
    const u32x4 z4 = (u32x4){0u, 0u, 0u, 0u};
    for (int i = gt; i < 2 * 2 * NVALID0 * 64; i += NGT) { const int c = i & 63, rr = (i >> 6) % NVALID0, gb = (i >> 6) / NVALID0, bb = gb & 1, grp = 3 + (gb >> 1);
        *(u32x4*)((bf16_t*)(ws + WS_MIX + (size_t)grp * SZ_G) + ((size_t)bb * LSEQ + rr) * BW + c * 8) = z4; }
}
__device__ __forceinline__ void zero_masked(unsigned char* ws, int gt, int NGT) {
    const u32x4 z4 = (u32x4){0u, 0u, 0u, 0u};
    for (int i = gt; i < 9 * 2 * NVALID0 * 64; i += NGT) { const int c = i & 63, rr = (i >> 6) % NVALID0, gb = (i >> 6) / NVALID0, bb = gb & 1, grp = gb >> 1;
        *(u32x4*)((bf16_t*)(ws + WS_MIX + (size_t)grp * SZ_G) + ((size_t)bb * LSEQ + rr) * BW + c * 8) = z4; }
    for (int i = gt; i < 2 * NVALID0 * 128; i += NGT) { const int c = i & 127, rr = (i >> 7) % NVALID0, bb = (i >> 7) / NVALID0;
        *(u32x4*)((float*)(ws + WS_LOGF) + ((size_t)bb * LSEQ + rr) * BW + c * 4) = z4; }
    for (int i = gt; i < 2 * 1024 * 14; i += NGT) { const int c = i % 14, ch = i / 14;
        *(u32x4*)((bf16_t*)(ws + WS_IT) + (size_t)ch * LSEQ + c * 8) = z4; }
}

constexpr int N_ATT = 16 * NCH, N_HGL = 2 * NCH * 4, N_POOL = 2 * NCH * 4, N_CONV = 2 * NCH;
typedef __attribute__((address_space(1))) unsigned char gchar_t;
__device__ __forceinline__ unsigned char* launder(unsigned char* q) { gchar_t* g = (gchar_t*)q; asm volatile("" : "+s"(g)); return (unsigned char*)g; }
#define PH_COMMON \
    int tid_ = threadIdx.x; asm volatile("" : "+v"(tid_)); int G_ = gridDim.x, bid_ = blockIdx.x; asm volatile("" : "+s"(G_), "+s"(bid_)); \
    const int tid = tid_, lane = tid & 63, wave = __builtin_amdgcn_readfirstlane(tid >> 6); \
    const int G = G_, bid = bid_, gw = bid * NWAVES + wave, NGW = G * NWAVES; unsigned char* ws = launder(p.ws); (void)lane; (void)gw; (void)NGW; (void)tid; (void)ws;

__device__ __forceinline__ void ph_pro(const Params& p, LAS unsigned char* lds, int l) { PH_COMMON
    prologue_misc(p, gw, NGW, lane);
    zero_masked(ws, gw * 64 + lane, NGW * 64);
    convert_layer(p, 0, lds, gw, NGW, wave, lane, 0); }
__device__ __forceinline__ void ph_p1(const Params& p, LAS unsigned char* lds, int l) { PH_COMMON
    if (l > 0) zero_masked_g34(ws, gw * 64 + lane, NGW * 64);
    pg8::SchedPlain S; S.T.init(MROWS, INC); S.G = G; S.c = bid; S.A = (const char*)(ws + WS_XN); S.B = (const char*)(ws + WS_WIN); S.astep = (size_t)DM * 2; S.bstep = (size_t)256 * DM * 2;
    EpiIn E{ws, (const float*)(ws + WS_LB) + l * BW};
    pg8::gemm_phase(lds, tid, DM, DM, DM, S, E);
    { const int nt_ = (MROWS / 256) * (INC / 256), rem = nt_ % G;
      if (rem == 0 || rem == G) skinny_p1(ws, (const float*)(ws + WS_LB) + l * BW, lds, bid, G, tid, wave, lane);
      else if (bid >= rem) { skinny_p1(ws, (const float*)(ws + WS_LB) + l * BW, lds, bid - rem, G - rem, tid, wave, lane);
          if (l + 1 < DEPTH) convert_layer(p, l + 1, lds, (bid - rem) * NWAVES + wave, (G - rem) * NWAVES, wave, lane, 2); }
      if ((rem == 0 || rem == G) && l + 1 < DEPTH) convert_layer(p, l + 1, lds, gw, NGW, wave, lane, 2); } }
__device__ __forceinline__ void ph_p2a(const Params& p, LAS unsigned char* lds, int l) { PH_COMMON
#ifdef PROBE_K1
    unsigned long long t_last = __builtin_amdgcn_s_memrealtime(); unsigned long long* sub = (unsigned long long*)(ws + WS_CTL + 12288);
#define SUBSTAMP(i) do { __syncthreads(); if (bid == 0 && tid == 0) { const unsigned long long now_ = __builtin_amdgcn_s_memrealtime(); sub[i] += now_ - t_last; t_last = now_; } } while (0)
    for (int it = bid; it < N_HGL; it += G) hgrn2_local(ws, lds, it, tid, wave, lane);
    SUBSTAMP(0);
    for (int it = bid + ((N_HGL + G - 1 - bid) / G) * G; it < N_HGL + N_ATT; it += G) attn_item(ws, lds, it - N_HGL, wave, lane);
    SUBSTAMP(1);
#else
    constexpr int NA = N_HGL + N_ATT; const int nst = (NA / G >= 2) ? (NA / G - 1) * G : 0;
    volatile LAS int* bw = (volatile LAS int*)(lds + 147448); unsigned* ctr = (unsigned*)(ws + WS_CTL + 14336) + l;
    int it = bid; bool dyn = false;
    for (;;) {
        if (!dyn && it >= nst) dyn = true;
        if (dyn) { __syncthreads(); if (tid == 0) *bw = nst + (int)atomicAdd(ctr, 1u); __syncthreads(); it = *bw; }
        if (it >= NA) break;
        if (it < N_HGL) hgrn2_local(ws, lds, it, tid, wave, lane);
        else attn_item(ws, lds, it - N_HGL, wave, lane);
        if (!dyn) it += G;
    }
#endif
    }
__device__ __forceinline__ void ph_p2b(const Params& p, LAS unsigned char* lds, int l) { PH_COMMON
#ifdef PROBE_K1
    unsigned long long t_last = __builtin_amdgcn_s_memrealtime(); unsigned long long* sub = (unsigned long long*)(ws + WS_CTL + 12288);
#endif
    hgrn2_scan(ws, gw * 64 + lane, NGW * 64);
#ifdef PROBE_K1
    SUBSTAMP(2);
#endif
    {
        constexpr int NB = N_POOL + N_CONV; const int nst = (NB / G >= 2) ? (NB / G - 1) * G : 0;
        volatile LAS int* bw = (volatile LAS int*)(lds + 147448); unsigned* ctr = (unsigned*)(ws + WS_CTL + 14336) + 4 + l;
        int it = bid; bool dyn = false;
        for (;;) {
            if (!dyn && it >= nst) dyn = true;
            if (dyn) { __syncthreads(); if (tid == 0) *bw = nst + (int)atomicAdd(ctr, 1u); __syncthreads(); it = *bw; }
            if (it >= NB) break;
            if (it < N_CONV) conv_item(ws, p.conv_w + (size_t)l * 3 * BW, it, tid);
            else pool_item(ws, l, it - N_CONV, wave, lane);
            if (!dyn) it += G;
        }
    }
#ifdef PROBE_K1
    SUBSTAMP(3);
#endif
    if (l + 1 < DEPTH) convert_layer(p, l + 1, lds, gw, NGW, wave, lane, 1);
#ifdef PROBE_K1
    SUBSTAMP(4);
#endif
    }
__device__ __forceinline__ void ph_p2c(const Params& p, LAS unsigned char* lds, int l) { PH_COMMON
    {
        const int nst = (N_HGL / G >= 2) ? (N_HGL / G - 1) * G : 0;
        volatile LAS int* bw = (volatile LAS int*)(lds + 147448); unsigned* ctr = (unsigned*)(ws + WS_CTL + 14336) + 8 + l;
        int it = bid; bool dyn = false;
        for (;;) {
            if (!dyn && it >= nst) dyn = true;
            if (dyn) { __syncthreads(); if (tid == 0) *bw = nst + (int)atomicAdd(ctr, 1u); __syncthreads(); it = *bw; }
            if (it >= N_HGL) break;
            hgrn2_out(ws, p.hg_norm_g + l * BW, lds, it, tid, wave, lane);
            if (!dyn) it += G;
        }
    } }
__device__ __forceinline__ void ph_p3(const Params& p, LAS unsigned char* lds, int l) { PH_COMMON
    const size_t wo = (l & 1) ? W2_OFF : 0;
    pg8::SchedBranch S; S.T.init(MROWS, DM); S.G = G; S.c = bid;
    S.A0 = (const char*)(ws + WS_MIX); S.A1 = (const char*)(ws + WS_POOLO); S.A2 = (const char*)(ws + WS_MIX + SZ_G); S.A3 = (const char*)(ws + WS_MIX + 2 * SZ_G);
    S.B = (const char*)(ws + WS_WBR + wo); S.astep = (size_t)BW * 2; S.bstep = (size_t)256 * BW * 2; S.bz = (size_t)DM * BW * 2;
    EpiBranch E{ws};
    pg8::gemm_phase(lds, tid, BW, BW, BW, S, E);
    skinny_p3(ws, wo, lds, bid, G, tid, wave, lane); }
__device__ __forceinline__ void ph_p4(const Params& p, LAS unsigned char* lds, int l) { PH_COMMON
    const size_t wo = (l & 1) ? W2_OFF : 0;
    pg8::SchedPlain S; S.T.init(MROWS, DM); S.G = G; S.c = bid; S.A = (const char*)(ws + WS_MIXEDB); S.B = (const char*)(ws + WS_WO + wo); S.astep = (size_t)DM * 2; S.bstep = (size_t)256 * DM * 2;
    EpiResid E{ws, (float*)(ws + WS_ST2)};
    pg8::gemm_phase(lds, tid, DM, DM, DM, S, E);
    skinny_resid(ws, WS_MIXEDB, DM, DM, WS_WO + wo, lds, bid, G, tid, wave, lane); }
__device__ __forceinline__ void ph_p5(const Params& p, LAS unsigned char* lds, int l) { PH_COMMON
    const size_t wo = (l & 1) ? W2_OFF : 0;
    pg8::SchedPlain S; S.T.init(MROWS, DFF); S.G = G; S.c = bid; S.A = (const char*)(ws + WS_XN); S.B = (const char*)(ws + WS_WUP + wo); S.astep = (size_t)DM * 2; S.bstep = (size_t)256 * DM * 2;
    EpiUp E{ws};
    pg8::gemm_phase(lds, tid, DM, DM, DM, S, E);
    skinny_p5(ws, wo, lds, bid, G, tid, wave, lane); }
__device__ __forceinline__ void ph_p6(const Params& p, LAS unsigned char* lds, int l) { PH_COMMON
    const size_t wo = (l & 1) ? W2_OFF : 0;
    pg8::SchedPlain S; S.T.init(MROWS, DM); S.G = G; S.c = bid; S.A = (const char*)(ws + WS_H); S.B = (const char*)(ws + WS_WDN + wo); S.astep = (size_t)PF * 2; S.bstep = (size_t)256 * PF * 2;
    EpiResid E{ws, (float*)(ws + WS_ST1)};
    pg8::gemm_phase(lds, tid, PF, PF, DFF, S, E);
    skinny_resid(ws, WS_H, DFF, PF, WS_WDN + wo, lds, bid, G, tid, wave, lane); }
__device__ __forceinline__ void ph_fin(const Params& p, LAS unsigned char* lds, int l) { PH_COMMON
    final_norm(p, gw, NGW, lane); }

#ifndef MEGA
#define MEGA 1
#endif
#ifdef DIAG
__global__ void k_chk(const unsigned char* base, size_t nbytes, int isf32, int code, unsigned* flag) {
    const size_t n = nbytes / 4; const unsigned* w = (const unsigned*)base; bool bad = false;
    for (size_t i = (size_t)blockIdx.x * blockDim.x + threadIdx.x; i < n; i += (size_t)gridDim.x * blockDim.x) {
        const unsigned u = w[i];
        if (isf32) bad |= (u & 0x7F800000u) == 0x7F800000u;
        else bad |= ((u & 0x7F80u) == 0x7F80u) || ((u & 0x7F800000u) == 0x7F800000u);
    }
    if (bad) atomicMin(flag, (unsigned)code);
}
__global__ void k_flaginit(unsigned* flag) { if (threadIdx.x == 0 && blockIdx.x == 0) *flag = 99u; }
__global__ void k_flagout(const unsigned* flag, float* out, size_t n) {
    const unsigned f = *flag; if (f == 99u) return;
    for (size_t i = (size_t)blockIdx.x * blockDim.x + threadIdx.x; i < n; i += (size_t)gridDim.x * blockDim.x) out[i] = (float)f;
}

#endif
#define XB_TMO      128
#define XB_XCNT(j)  (256  + 64 * (j))
#define XB_XSUB(j)  (1280 + 64 * (j))
#define XB_XGEN(j)  (2304 + 64 * (j))
#define XB_TOP      3328
#define XB_TOPGEN   3392
#define XCD_BAR_WORDS 3456
#define XB_SPIN_CAP (1u << 22)
__device__ __forceinline__ unsigned xb_ld(unsigned* p)              { return __hip_atomic_load(p, __ATOMIC_RELAXED, __HIP_MEMORY_SCOPE_AGENT); }
__device__ __forceinline__ unsigned xb_add(unsigned* p, unsigned v) { return __hip_atomic_fetch_add(p, v, __ATOMIC_RELAXED, __HIP_MEMORY_SCOPE_AGENT); }
__device__ __forceinline__ unsigned xb_xcc_id() { return (unsigned)__builtin_amdgcn_s_getreg((3 << 11) | 20) & 0xFu; }
#define XB_SPIN(cond, bar) do { unsigned _sp = 0; while (cond) { __builtin_amdgcn_s_sleep(1); \
    if ((++_sp & 255u) == 0u) { if (xb_ld(&(bar)[XB_TMO])) break; if (_sp > XB_SPIN_CAP) { atomicAdd(&(bar)[XB_TMO], 1u); break; } } } } while (0)
struct XcdBarrier { unsigned* bar; unsigned x; volatile LAS unsigned* st; };
__device__ __forceinline__ XcdBarrier xcd_barrier_post(unsigned* bar, volatile LAS unsigned* st) {
    XcdBarrier b; b.bar = bar; b.x = xb_xcc_id(); b.st = st;
    if (threadIdx.x == 0) (void)xb_add(&bar[XB_XCNT(b.x)], 1u);
    return b;
}
__device__ __forceinline__ void xcd_barrier_complete(unsigned* bar, unsigned x, unsigned& nloc, unsigned& nx) {
    const unsigned G = gridDim.x * gridDim.y * gridDim.z;
    unsigned sum, cnt, mine, sp = 0u;
    for (;;) {
        sum = 0u; cnt = 0u; mine = 0u;
#pragma unroll
        for (unsigned j = 0; j < 16; ++j) { const unsigned c = xb_ld(&bar[XB_XCNT(j)]); sum += c; cnt += (c > 0u) ? 1u : 0u; mine = (j == x) ? c : mine; }
        if (sum == G) break;
        __builtin_amdgcn_s_sleep(1);
        if ((++sp & 255u) == 0u) { if (xb_ld(&bar[XB_TMO])) break; if (sp > XB_SPIN_CAP) { atomicAdd(&bar[XB_TMO], 1u); break; } }
    }
    nloc = mine > 0u ? mine : 1u; nx = cnt > 0u ? cnt : 1u;
}
__device__ __forceinline__ void xcd_barrier(const XcdBarrier& b) {
    asm volatile("s_waitcnt vmcnt(0)" ::: "memory");
    __syncthreads();
    if (threadIdx.x == 0) {
        unsigned* bar = b.bar;
        __builtin_amdgcn_s_waitcnt(0);
        unsigned nloc = b.st[0], nx = b.st[1];
        if (nloc == 0u) { xcd_barrier_complete(bar, b.x, nloc, nx); b.st[0] = nloc; b.st[1] = nx; }
        const unsigned old = xb_add(&bar[XB_XSUB(b.x)], 1u);
        const unsigned gen = old / nloc;
        if (old + 1u == (gen + 1u) * nloc) {
            __builtin_amdgcn_fence(__ATOMIC_RELEASE, "agent");
            asm volatile("s_waitcnt vmcnt(0)" ::: "memory");
            const unsigned og = xb_add(&bar[XB_TOP], 1u);
            const unsigned tg = og / nx;
            if (og + 1u == (tg + 1u) * nx) xb_add(&bar[XB_TOPGEN], 1u);
            else XB_SPIN(xb_ld(&bar[XB_TOPGEN]) == tg, bar);
            __builtin_amdgcn_fence(__ATOMIC_ACQUIRE, "agent");
            xb_add(&bar[XB_XGEN(b.x)], 1u);
            asm volatile("s_waitcnt vmcnt(0)" ::: "memory");
        } else {
            XB_SPIN(xb_ld(&bar[XB_XGEN(b.x)]) == gen, bar);
            __builtin_amdgcn_fence(__ATOMIC_ACQUIRE, "agent");
            asm volatile("s_waitcnt vmcnt(0)" ::: "memory");
        }
    }
    __syncthreads();
}

#if MEGA
__global__ void __launch_bounds__(NT, 2) fwd_megakernel(Params p) {
    extern __shared__ __attribute__((aligned(16))) unsigned char lds_raw[];
    LAS unsigned char* lds = (LAS unsigned char*)lds_raw;
    cg::grid_group grid = cg::this_grid();
    volatile LAS unsigned* bst = (volatile LAS unsigned*)(lds + 147440);
    if (threadIdx.x == 0) { bst[0] = 0u; bst[1] = 0u; }
    __syncthreads();
    const XcdBarrier bar = xcd_barrier_post((unsigned*)(p.ws + WS_CTL), bst);
#ifdef PROBE_K1
    if (blockIdx.x == 0 && threadIdx.x == 0) ((unsigned long long*)(p.ws + WS_CTL + 8192))[0] = __builtin_amdgcn_s_memrealtime();
#endif
#pragma unroll 1
    for (int ph = 0; ph < 1 + DEPTH * 8; ++ph) {
        const int l = ph == 0 ? 0 : (ph - 1) >> 3, k = ph == 0 ? 0 : (ph - 1) & 7;
        if (ph == 0) ph_pro(p, lds, 0);
        else if (k == 0) ph_p1(p, lds, l);
        else if (k == 1) ph_p2a(p, lds, l);
        else if (k == 2) ph_p2b(p, lds, l);
        else if (k == 3) ph_p2c(p, lds, l);
        else if (k == 4) ph_p3(p, lds, l);
        else if (k == 5) ph_p4(p, lds, l);
        else if (k == 6) ph_p5(p, lds, l);
        else ph_p6(p, lds, l);
        xcd_barrier(bar);
        if (p.ws == nullptr) grid.sync();
#ifdef PROBE_K1
        if (blockIdx.x == 0 && threadIdx.x == 0) ((unsigned long long*)(p.ws + WS_CTL + 8192))[ph + 1] = __builtin_amdgcn_s_memrealtime();
#endif
    }
#ifdef PROBE_K1
    __syncthreads();
#endif
    ph_fin(p, lds, 0);
}
#else
#define MKK(NAME, FN) __global__ void __launch_bounds__(NT, 2) NAME(Params p, int l) { \
    extern __shared__ __attribute__((aligned(16))) unsigned char lds_raw[]; FN(p, (LAS unsigned char*)lds_raw, l); }
MKK(k_pro, ph_pro) MKK(k_p1, ph_p1) MKK(k_p2a, ph_p2a) MKK(k_p2b, ph_p2b) MKK(k_p2c, ph_p2c) MKK(k_p3, ph_p3) MKK(k_p4, ph_p4) MKK(k_p5, ph_p5) MKK(k_p6, ph_p6) MKK(k_fin, ph_fin)
__device__ __forceinline__ void ph_poolonly(const Params& p, LAS unsigned char* lds, int l) { PH_COMMON
    for (int it = bid; it < N_POOL; it += G) pool_item(ws, l, it, wave, lane); }
MKK(k_poolonly, ph_poolonly)
#endif

extern "C" void kernel_launch(void* const* d_in, const int* in_sizes, int n_in, void* d_out, int out_size, void* d_ws, size_t ws_size, hipStream_t stream) {
    static int grid = 0;
    if (grid == 0) {
        int dev = 0, cus = 0;
        (void)hipGetDevice(&dev); (void)hipDeviceGetAttribute(&cus, hipDeviceAttributeMultiprocessorCount, dev);
#if MEGA
        int per = 0;
        (void)hipFuncSetAttribute((const void*)fwd_megakernel, hipFuncAttributeMaxDynamicSharedMemorySize, LDS_BYTES);
        (void)hipOccupancyMaxActiveBlocksPerMultiprocessor(&per, (const void*)fwd_megakernel, NT, LDS_BYTES);
        if (per < 1) per = 1;
        grid = cus * per;
#else
        const void* ks[] = {(const void*)k_pro, (const void*)k_p1, (const void*)k_p2a, (const void*)k_p2b, (const void*)k_p2c, (const void*)k_p3, (const void*)k_p4, (const void*)k_p5, (const void*)k_p6, (const void*)k_fin};
        for (int i = 0; i < 10; ++i) (void)hipFuncSetAttribute(ks[i], hipFuncAttributeMaxDynamicSharedMemorySize, LDS_BYTES);
        grid = cus;
#endif
        if (n_in != 15 || ws_size < WS_END) { fprintf(stderr, "kernel_launch: unexpected n_in %d / ws %zu (need %zu)\n", n_in, ws_size, (size_t)WS_END); }
    }
    Params p{};
    p.x = (const float*)d_in[0]; p.meta = (const float*)d_in[1]; p.lb_logits = (const float*)d_in[2]; p.norm1_g = (const float*)d_in[3]; p.w_in = (const float*)d_in[4];
    p.hg_norm_g = (const float*)d_in[5]; p.pool_w = (const float*)d_in[6]; p.pool_scale = (const float*)d_in[7]; p.conv_w = (const float*)d_in[8]; p.w_branch = (const float*)d_in[9];
    p.w_o = (const float*)d_in[10]; p.norm2_g = (const float*)d_in[11]; p.w_up = (const float*)d_in[12]; p.w_down = (const float*)d_in[13]; p.final_g = (const float*)d_in[14];
    p.out = (float*)d_out; p.ws = (unsigned char*)d_ws;
#if MEGA
    (void)hipMemsetAsync((char*)d_ws + WS_CTL, 0, 16384, stream);
    void* args[] = {&p};
    hipError_t e = hipLaunchCooperativeKernel((void*)fwd_megakernel, dim3(grid), dim3(NT), args, LDS_BYTES, stream);
    if (e != hipSuccess) fprintf(stderr, "cooperative launch failed: %s (grid %d)\n", hipGetErrorString(e), grid);
#else
#define LK(K, L) hipLaunchKernelGGL(K, dim3(grid), dim3(NT), LDS_BYTES, stream, p, (int)(L))
#ifdef DIAG
    unsigned char* W = (unsigned char*)d_ws; unsigned* flag = (unsigned*)(W + WS_END + 4096);
#define CHK(off, bytes, f32, code) hipLaunchKernelGGL(k_chk, dim3(1024), dim3(256), 0, stream, (const unsigned char*)(W + (off)), (size_t)(bytes), (int)(f32), (int)(code), flag)
    hipLaunchKernelGGL(k_flaginit, dim3(1), dim3(64), 0, stream, flag);
    LK(k_pro, 0);
    CHK(WS_X, (size_t)ROWS * DM * 4, 1, 1); CHK(WS_XN, (size_t)ROWS * DM * 2, 0, 1); CHK(WS_WIN, WS_X - WS_WIN, 0, 1); CHK(WS_LB, WS_DEC, 1, 1); CHK(WS_ST1, (size_t)ROWS * 64, 1, 1);
    LK(k_p1, 0);
    CHK(WS_MIX, 9 * SZ_G, 0, 2); CHK(WS_IT, 2 * SZ_G, 0, 3); CHK(WS_GATE, (size_t)ROWS * DFF * 2, 0, 4); CHK(WS_LOGF, (size_t)ROWS * BW * 4, 1, 5);
    CHK(WS_PWT, 4 * 4 * 128 * 128 * 2, 0, 1);
    LK(k_poolonly, 0);
    CHK(WS_POOLO, SZ_G, 0, 6);
    LK(k_p2a, 0);
    CHK(WS_POOLO, SZ_G, 0, 16); CHK(WS_DS, (size_t)ROWS * BW * 4, 1, 7); CHK(WS_LOGF, (size_t)ROWS * BW * 4, 1, 8); CHK(WS_MIX + SZ_G, 2 * SZ_G, 0, 9);
    LK(k_p2b, 0);
    CHK(WS_SPREV, SZ_G, 0, 10);
    LK(k_p2c, 0);
    CHK(WS_MIX, SZ_G, 0, 11);
    LK(k_p3, 0);
    CHK(WS_MIXEDB, 2 * SZ_G, 0, 12);
    LK(k_p4, 0);
    CHK(WS_X, (size_t)ROWS * DM * 4, 1, 13);
    LK(k_p5, 0);
    CHK(WS_H, (size_t)ROWS * DFF * 2, 0, 14);
    LK(k_p6, 0);
    CHK(WS_X, (size_t)ROWS * DM * 4, 1, 15);
    LK(k_fin, 0);
    hipLaunchKernelGGL(k_flagout, dim3(1024), dim3(256), 0, stream, (const unsigned*)flag, (float*)d_out, (size_t)BATCH * SEQ * DM);
#else
    LK(k_pro, 0);
    for (int l = 0; l < DEPTH; ++l) {
        LK(k_p1, l); LK(k_p2a, l); LK(k_p2b, l); LK(k_p2c, l); LK(k_p3, l); LK(k_p4, l); LK(k_p5, l); LK(k_p6, l);
    }
    LK(k_fin, 0);
#endif
#endif
}
```
